# Optimizing an MI355X kernel written in HIP

```python
import jax, jax.numpy as jnp
from jax import lax
import numpy as np

D_MODEL = 4096
BATCH = 4
SEQ = 4096
DEPTH = 1

DN_HEADS = 16
DN_HEAD_DIM = 128
DN_WIDTH = DN_HEADS * DN_HEAD_DIM
DN_CONV = 4
DN_CHUNK = 64
SW_GROUPS = ((128, 1), (512, 4), (2048, 16))
N_SW_GROUPS = 3
SW_HEADS = 8
SW_HEAD_DIM = 128
SW_GROUP_WIDTH = SW_HEADS * SW_HEAD_DIM
ROPE_THETA = 500000.0
ROPE_DIM = SW_HEAD_DIM // 4
N_BRANCHES = 2
D_FF = 11008
FFN_CONV = 3
NORM_EPS = 1e-6
N_MOD = 6
IN_SPLITS = (3 * DN_WIDTH, DN_WIDTH, DN_HEADS, DN_HEADS, 3 * N_SW_GROUPS * SW_GROUP_WIDTH, N_BRANCHES * D_MODEL)
IN_WIDTH = 3 * DN_WIDTH + DN_WIDTH + 2 * DN_HEADS + 3 * N_SW_GROUPS * SW_GROUP_WIDTH + N_BRANCHES * D_MODEL

kernel_name = "hybrid_deltanet_dilated_swa_convffn"


def rms_norm(x, eps=NORM_EPS):
    xf = x.astype(jnp.float32)
    return (xf * lax.rsqrt(jnp.mean(xf * xf, -1, keepdims=True) + eps)).astype(x.dtype)


def l2_norm(x, eps=NORM_EPS):
    return x * lax.rsqrt(jnp.sum(x * x, -1, keepdims=True) + eps)


def causal_dwconv(x, w):
    k_w = w.shape[0]
    t_len = x.shape[1]
    xp = jnp.pad(x, ((0, 0), (k_w - 1, 0), (0, 0)))
    return sum(w[j] * xp[:, j:j + t_len] for j in range(k_w))


def partial_rope(x, positions):
    half = ROPE_DIM // 2
    inv_freq = ROPE_THETA ** (-(jnp.arange(half, dtype=jnp.float32) * 2.0 / ROPE_DIM))
    ang = positions.astype(jnp.float32)[..., None] * inv_freq
    cos = jnp.cos(ang)[:, :, None, :]
    sin = jnp.sin(ang)[:, :, None, :]
    xf = x.astype(jnp.float32)
    x1, x2, rest = xf[..., :half], xf[..., half:ROPE_DIM], xf[..., ROPE_DIM:]
    out = jnp.concatenate([x1 * cos - x2 * sin, x2 * cos + x1 * sin, rest], -1)
    return out.astype(x.dtype)


def dilated_window_attention(q, k, v, dilation, span):
    b, t_len, h, dh = q.shape
    n = t_len // dilation
    nb = -(-n // span)
    npad = nb * span
    bd = b * dilation

    def to_strided(t):
        t = t.reshape(b, n, dilation, h, dh).transpose(0, 2, 1, 3, 4).reshape(bd, n, h, dh)
        return jnp.pad(t, ((0, 0), (0, npad - n), (0, 0), (0, 0)))

    def band(t):
        tb = jnp.pad(t, ((0, 0), (span, 0), (0, 0), (0, 0))).reshape(bd, nb + 1, span, h, dh)
        return jnp.concatenate([tb[:, :-1], tb[:, 1:]], axis=2)

    qb = to_strided(q).reshape(bd, nb, span, h, dh)
    kb = band(to_strided(k))
    vb = band(to_strided(v))
    s = jnp.einsum('znqhd,znkhd->znhqk', qb, kb, preferred_element_type=jnp.float32) * (dh ** -0.5)
    qi = jnp.arange(span)[:, None]
    ki = jnp.arange(2 * span)[None, :]
    rel = span + qi - ki
    blk = jnp.arange(nb)[:, None, None]
    valid = (rel >= 0) & (rel <= span) & (blk * span + ki - span >= 0)
    s = jnp.where(valid[None, :, None], s, -jnp.inf)
    m = jnp.max(s, -1, keepdims=True)
    p = jnp.exp(s - m)
    den = jnp.sum(p, -1, keepdims=True)
    o = jnp.einsum('znhqk,znkhd->znqhd', (p / den).astype(v.dtype), vb)
    lse = (m + jnp.log(den))[..., 0]
    o = o.reshape(bd, npad, h, dh)[:, :n].reshape(b, dilation, n, h, dh)
    o = o.transpose(0, 2, 1, 3, 4).reshape(b, t_len, h, dh)
    lse = lse.transpose(0, 1, 3, 2).reshape(bd, npad, h)[:, :n].reshape(b, dilation, n, h)
    lse = lse.transpose(0, 2, 1, 3).reshape(b, t_len, h)
    return o, lse


def gated_delta_rule(q, k, v, beta, g):
    b, t_len, h, dk = q.shape
    dv = v.shape[-1]
    cs = DN_CHUNK
    n = t_len // cs

    def chunk_vec(t):
        return t.reshape(b, n, cs, h, t.shape[-1]).transpose(0, 1, 3, 2, 4)

    def chunk_scalar(t):
        return t.reshape(b, n, cs, h).transpose(0, 1, 3, 2)

    qc, kc, vc = chunk_vec(q), chunk_vec(k), chunk_vec(v)
    bc, gcum = chunk_scalar(beta), jnp.cumsum(chunk_scalar(g), -1)
    tri = jnp.tril(jnp.ones((cs, cs), bool))
    strict = jnp.tril(jnp.ones((cs, cs), bool), -1)
    gamma = jnp.exp(jnp.where(tri, gcum[..., :, None] - gcum[..., None, :], -jnp.inf))
    kbeta = kc * bc[..., None]
    a_mat = jnp.where(strict, jnp.einsum('bnhid,bnhjd->bnhij', kbeta, kc) * gamma, 0.0)
    lhs = jnp.eye(cs, dtype=jnp.float32) + a_mat
    u = lax.linalg.triangular_solve(lhs, vc * bc[..., None], left_side=True, lower=True)
    w = lax.linalg.triangular_solve(lhs, kbeta * jnp.exp(gcum)[..., None], left_side=True, lower=True)
    aqk = jnp.einsum('bnhid,bnhjd->bnhij', qc, kc) * gamma
    qdec = qc * jnp.exp(gcum)[..., None]
    glast = gcum[..., -1]
    kdec = kc * jnp.exp(glast[..., None] - gcum)[..., None]

    def step(state, xs):
        u_i, w_i, qd_i, aqk_i, kd_i, gl_i = xs
        v_new = u_i - jnp.einsum('bhck,bhkv->bhcv', w_i, state)
        o_i = jnp.einsum('bhck,bhkv->bhcv', qd_i, state) + jnp.einsum('bhij,bhjv->bhiv', aqk_i, v_new)
        state = state * jnp.exp(gl_i)[..., None, None] + jnp.einsum('bhck,bhcv->bhkv', kd_i, v_new)
        return state, o_i

    xs = tuple(jnp.moveaxis(t, 1, 0) for t in (u, w, qdec, aqk, kdec, glast))
    s0 = jnp.zeros((b, h, dk, dv), jnp.float32)
    _, o = lax.scan(step, s0, xs)
    return o.transpose(1, 0, 3, 2, 4).reshape(b, t_len, h, dv)


def setup_inputs(seed: int = 0) -> dict:
    key = jax.random.key(seed)
    ks = jax.random.split(key, 20)
    f32 = jnp.float32
    nrm = lambda k, shape, scale: jax.random.normal(k, shape, f32) * scale
    dt = jnp.exp(jax.random.uniform(ks[9], (DEPTH, DN_HEADS), f32, np.log(1e-3), np.log(1e-1)))
    return {
        "x": nrm(ks[0], (BATCH, SEQ, D_MODEL), 1.0),
        "c": nrm(ks[1], (BATCH, D_MODEL), 1.0),
        "positions": jnp.broadcast_to(jnp.arange(SEQ, dtype=jnp.int32), (BATCH, SEQ)),
        "w_ada": nrm(ks[2], (DEPTH, D_MODEL, N_MOD * D_MODEL), 0.5 * D_MODEL ** -0.5),
        "b_ada": nrm(ks[3], (DEPTH, N_MOD * D_MODEL), 0.02),
        "w_in": nrm(ks[4], (DEPTH, D_MODEL, IN_WIDTH), D_MODEL ** -0.5),
        "b_gate": nrm(ks[5], (DEPTH, N_BRANCHES * D_MODEL), 0.02),
        "conv_qkv": nrm(ks[6], (DEPTH, DN_CONV, 3 * DN_WIDTH), DN_CONV ** -0.5),
        "a_log": jnp.log(jax.random.uniform(ks[7], (DEPTH, DN_HEADS), f32, 1.0, 16.0)),
        "dt_bias": dt + jnp.log(-jnp.expm1(-dt)),
        "o_norm_gain": 1.0 + nrm(ks[10], (DEPTH, DN_HEAD_DIM), 0.02),
        "w_a_proj": nrm(ks[11], (DEPTH, DN_WIDTH, D_MODEL), DN_WIDTH ** -0.5),
        "q_norm_gain": 1.0 + nrm(ks[12], (DEPTH, SW_HEAD_DIM), 0.02),
        "k_norm_gain": 1.0 + nrm(ks[13], (DEPTH, SW_HEAD_DIM), 0.02),
        "w_b_proj": nrm(ks[14], (DEPTH, SW_GROUP_WIDTH, D_MODEL), SW_GROUP_WIDTH ** -0.5),
        "w_o": nrm(ks[15], (DEPTH, D_MODEL, D_MODEL), D_MODEL ** -0.5),
        "w_up": nrm(ks[16], (DEPTH, D_MODEL, 2 * D_FF), D_MODEL ** -0.5),
        "conv_ffn": nrm(ks[17], (DEPTH, FFN_CONV, 2 * D_FF), FFN_CONV ** -0.5),
        "w_down": nrm(ks[18], (DEPTH, D_FF, D_MODEL), D_FF ** -0.5),
    }


def reference(x, c, positions, w_ada, b_ada, w_in, b_gate, conv_qkv, a_log, dt_bias, o_norm_gain,
              w_a_proj, q_norm_gain, k_norm_gain, w_b_proj, w_o, w_up, conv_ffn, w_down):
    b, t_len, _ = x.shape
    split_at = np.cumsum(IN_SPLITS)[:-1].tolist()
    for layer in range(DEPTH):
        mod = (jax.nn.silu(c) @ w_ada[layer] + b_ada[layer])[:, None, :]
        shift_mix, scale_mix, gate_mix, shift_ffn, scale_ffn, gate_ffn = jnp.split(mod, N_MOD, axis=-1)

        h = rms_norm(x) * (1 + scale_mix) + shift_mix
        proj = h @ w_in[layer]
        qkv_a, z_a, b_a, a_a, qkv_b, gate_logits = jnp.split(proj, split_at, axis=-1)

        qkv_a = jax.nn.silu(causal_dwconv(qkv_a, conv_qkv[layer])).astype(jnp.float32)
        qa, ka, va = [t.reshape(b, t_len, DN_HEADS, DN_HEAD_DIM) for t in jnp.split(qkv_a, 3, axis=-1)]
        qa = l2_norm(qa) * (DN_HEAD_DIM ** -0.5)
        ka = l2_norm(ka)
        beta = jax.nn.sigmoid(b_a.astype(jnp.float32))
        g = -jnp.exp(a_log[layer].astype(jnp.float32)) * jax.nn.softplus(
            a_a.astype(jnp.float32) + dt_bias[layer].astype(jnp.float32))
        o_a = gated_delta_rule(qa, ka, va, beta, g).astype(x.dtype)
        o_a = rms_norm(o_a) * o_norm_gain[layer] * jax.nn.silu(z_a.reshape(b, t_len, DN_HEADS, DN_HEAD_DIM))
        y_a = o_a.reshape(b, t_len, DN_WIDTH) @ w_a_proj[layer]

        sw = qkv_b.reshape(b, t_len, N_SW_GROUPS, 3, SW_HEADS, SW_HEAD_DIM)
        outs, lses = [], []
        for gi, (window, dilation) in enumerate(SW_GROUPS):
            qg = partial_rope(rms_norm(sw[:, :, gi, 0]) * q_norm_gain[layer], positions)
            kg = partial_rope(rms_norm(sw[:, :, gi, 1]) * k_norm_gain[layer], positions)
            o_g, lse_g = dilated_window_attention(qg, kg, sw[:, :, gi, 2], dilation, window // dilation)
            outs.append(o_g)
            lses.append(lse_g)
        alpha = jax.nn.softmax(jnp.stack(lses, 0), axis=0)
        o_b = jnp.sum(alpha[..., None] * jnp.stack(outs, 0).astype(jnp.float32), axis=0).astype(x.dtype)
        y_b = o_b.reshape(b, t_len, SW_GROUP_WIDTH) @ w_b_proj[layer]

        gate_a, gate_b = jnp.split(jax.nn.sigmoid(gate_logits + b_gate[layer]), N_BRANCHES, axis=-1)
        x = x + gate_mix * ((gate_a * y_a + gate_b * y_b) @ w_o[layer])

        h = rms_norm(x) * (1 + scale_ffn) + shift_ffn
        up = causal_dwconv(h @ w_up[layer], conv_ffn[layer])
        u_gate, u_val = jnp.split(up, 2, axis=-1)
        x = x + gate_ffn * ((jax.nn.silu(u_gate) * u_val) @ w_down[layer])
    return x
```

```cpp
#include <hip/hip_runtime.h>
#include <cstdio>
#include <cstdint>
#include <type_traits>
namespace pg8 {
#define PG8_LAS __attribute__((address_space(3)))
typedef unsigned short bf16_t;
typedef short bf16x8 __attribute__((ext_vector_type(8)));
typedef float f32x4 __attribute__((ext_vector_type(4)));
typedef unsigned u32x4 __attribute__((ext_vector_type(4)));
constexpr int BM = 256, BK = 64, HALF = 128, HTB = HALF * BK * 2  , STAGE_BYTES = 8 * HTB, NXCD = 8, WGM = 8;

__host__ __device__ __forceinline__ int lds_byte(int r, int c) { const int st = (r >> 4) * 2 + (c >> 5), rr = r & 15, cc = c & 31, ob = rr * 64 + cc * 2; return st * 1024 + (ob ^ (((ob >> 9) & 1) << 5)); }
__host__ __device__ __forceinline__ void stage_rc(int b, int& R, int& C) { const int st = b / 1024, sb = b % 1024, swz = sb ^ (((sb >> 9) & 1) << 5); R = (st >> 1) * 16 + swz / 64; C = (st & 1) * 32 + (swz % 64) / 2; }
__host__ __device__ __forceinline__ int perm32(int rho) { const int n = rho >> 4, i = rho & 15; return 8 * (i >> 2) + 4 * n + (i & 3); }

struct Unit { int pm, pn; };
struct Gemm { const bf16_t* A; const bf16_t* Bt; int M, N, K; };

struct StaticOrder {
    int nM, nN, nwg, G, c;
    __host__ __device__ void init(int M, int N, int G_, int c_) { nM = M / BM; nN = N / BM; nwg = nM * nN; G = G_; c = c_; }
    __host__ __device__ bool next(int i, Unit& u) const {
        const long L = (long)i * G + c; if (L >= nwg) return false;
        int wgid = (int)L; { const int q = nwg / NXCD, r = nwg % NXCD, xcd = wgid % NXCD, off = wgid / NXCD; wgid = (xcd < r ? xcd * (q + 1) : r * (q + 1) + (xcd - r) * q) + off; }
        const int ngrp = nM >= WGM ? nM / WGM : 1, nig = WGM * nN; int gid = wgid / nig; if (gid >= ngrp) gid = ngrp - 1;
        const int fm = gid * WGM, gsz = (gid == ngrp - 1) ? (nM - fm) : WGM, loc = wgid - gid * nig;
        u.pm = fm + (loc % gsz); u.pn = loc / gsz; return true;
    }
    __device__ __forceinline__ void a_ready(const Unit&) const {}
    __device__ __forceinline__ void done(const Unit&) const {}
};

__device__ __forceinline__ unsigned cvt_pk_bf16(float lo, float hi) { unsigned r; asm volatile("v_cvt_pk_bf16_f32 %0, %1, %2" : "=v"(r) : "v"(lo), "v"(hi)); return r; }
__device__ __forceinline__ float fexp(float x) { return __builtin_amdgcn_exp2f(x * 1.4426950408889634f); }
__device__ __forceinline__ float bflo(unsigned w) { return __uint_as_float(w << 16); }
__device__ __forceinline__ float bfhi(unsigned w) { return __uint_as_float(w & 0xffff0000u); }
__device__ __forceinline__ float sigmoidf_(float x) { return __builtin_amdgcn_rcpf(1.0f + fexp(-x)); }
__device__ __forceinline__ float softplusf_(float x) { return fmaxf(x, 0.f) + log1pf(fexp(-fabsf(x))); }


struct AMapNat {
    __device__ static __forceinline__ int voff(int R, int C, int K) { return (R * K + C) * 2; }
    __device__ static __forceinline__ size_t hstep(int K) { return (size_t)HALF * K * 2; }
    __device__ static __forceinline__ size_t tstep(int K) { return (size_t)BM * K * 2; }
};
struct AMapConv {
    __device__ static __forceinline__ int voff(int R, int C, int K) { const int wr = R >> 6, m = (R >> 4) & 3, fr = R & 15; return ((128 * wr - 2 + 8 * fr + m) * K + C) * 2; }
    __device__ static __forceinline__ size_t hstep(int K) { return (size_t)4 * K * 2; }
    __device__ static __forceinline__ size_t tstep(int K) { return (size_t)254 * K * 2; }
};
typedef int i32x4 __attribute__((ext_vector_type(4)));
struct MmaBf16 { typedef f32x4 acc_t; __device__ static __forceinline__ acc_t zero() { return (f32x4){0.f, 0.f, 0.f, 0.f}; }
    __device__ static __forceinline__ acc_t mma(bf16x8 b, bf16x8 a, acc_t c) { return __builtin_amdgcn_mfma_f32_16x16x32_bf16(b, a, c, 0, 0, 0); } };
struct MmaI8 { typedef i32x4 acc_t; __device__ static __forceinline__ acc_t zero() { return (i32x4){0, 0, 0, 0}; }
    __device__ static __forceinline__ acc_t mma(bf16x8 b, bf16x8 a, acc_t c) { return __builtin_amdgcn_mfma_i32_16x16x64_i8(__builtin_bit_cast(i32x4, b), __builtin_bit_cast(i32x4, a), c, 0, 0, 0); } };

struct EpiBf16Plain {
    static constexpr bool PERM = true, AFTER_DRAIN = false; static constexpr int NSTORE = 16;
    bf16_t* O; int ldc;
    __device__ __forceinline__ void operator()(const f32x4 (&acc)[2][2][4][2], const Unit& u, int wr, int wc, int fr, int fq) const {
        const int row0 = u.pm * BM + wr * 64 + fr, col0 = u.pn * BM + wc * 32 + 8 * fq;
#ifdef PROBE_NOSTORE
        if (O == nullptr) {
#pragma unroll
            for (int ai = 0; ai < 2; ++ai)
#pragma unroll
                for (int m = 0; m < 4; ++m)
#pragma unroll
                    for (int bj = 0; bj < 2; ++bj) asm volatile("" :: "v"(acc[ai][bj][m][0]), "v"(acc[ai][bj][m][1]));
            return; }
#endif
#pragma unroll
        for (int ai = 0; ai < 2; ++ai)
#pragma unroll
            for (int m = 0; m < 4; ++m) { bf16_t* rowp = O + (size_t)(row0 + ai * HALF + m * 16) * ldc + col0;
#pragma unroll
                for (int bj = 0; bj < 2; ++bj) { const f32x4 v0 = acc[ai][bj][m][0], v1 = acc[ai][bj][m][1];
                    u32x4 w; w.x = cvt_pk_bf16(v0[0], v0[1]); w.y = cvt_pk_bf16(v0[2], v0[3]); w.z = cvt_pk_bf16(v1[0], v1[1]); w.w = cvt_pk_bf16(v1[2], v1[3]);
                    *(u32x4*)(rowp + bj * HALF) = w; } }
    }
};


__device__ __forceinline__ float dpp_shr1(float x) { return __builtin_bit_cast(float, __builtin_amdgcn_update_dpp(0, __builtin_bit_cast(int, x), 0x111, 0xf, 0xf, true)); }
template <bool I8> struct EpiUpConv {
    static constexpr bool PERM = true, AFTER_DRAIN = false; static constexpr int NSTORE = 0;
    bf16_t* ACT; const float* conv; PG8_LAS float* xl; const float* sA; const float* sB; int Mtok;
    typedef float f32x2 __attribute__((ext_vector_type(2)));
    template <class ACC> __device__ __forceinline__ void body(const ACC (&acc)[2][2][4][2], const Unit& u, int wc, int fq, int tok0, const float (&sa)[8], bool from_lds, const PG8_LAS float* xs, const f32x4 (&cw)[3][2][2], const float (&m1)[8], const float (&m2)[8], unsigned (&outw)[8][4]) const {
#pragma unroll
        for (int n = 0; n < 2; ++n)
#pragma unroll
            for (int ep = 0; ep < 2; ++ep) { const int e0 = 2 * ep, c0 = 4 * n + e0;
                f32x2 g[8], v[8];
                f32x2 sg = (f32x2){1.f, 1.f}, sv = sg;
                if (I8) { const float* sbp = sB + 256 * u.pn + 32 * wc + 8 * fq + c0; sg = (f32x2){sbp[0], sbp[1]}; sv = (f32x2){sbp[128], sbp[129]}; }
#pragma unroll
                for (int j = 0; j < 8; ++j) { g[j] = (f32x2){(float)acc[j >> 2][0][j & 3][n][e0], (float)acc[j >> 2][0][j & 3][n][e0 + 1]}; v[j] = (f32x2){(float)acc[j >> 2][1][j & 3][n][e0], (float)acc[j >> 2][1][j & 3][n][e0 + 1]};
                    if (I8) { g[j] = g[j] * sg * sa[j]; v[j] = v[j] * sv * sa[j]; } }
                f32x2 gm1 = (f32x2){dpp_shr1(g[7].x), dpp_shr1(g[7].y)}, gm2 = (f32x2){dpp_shr1(g[6].x), dpp_shr1(g[6].y)}, vm1 = (f32x2){dpp_shr1(v[7].x), dpp_shr1(v[7].y)}, vm2 = (f32x2){dpp_shr1(v[6].x), dpp_shr1(v[6].y)};
                {
                  f32x2 l0, l1, l2, l3; const unsigned xa = (unsigned)(size_t)(xs + c0);
                  asm volatile("ds_read_b64 %0, %4\n\tds_read_b64 %1, %4 offset:32\n\tds_read_b64 %2, %4 offset:64\n\tds_read_b64 %3, %4 offset:96\n\ts_waitcnt lgkmcnt(0)" : "=&v"(l0), "=&v"(l1), "=&v"(l2), "=&v"(l3) : "v"(xa) : "memory");
                  if (from_lds) { gm2 = l0; gm1 = l1; vm2 = l2; vm1 = l3; } }
                const f32x2 w0 = (f32x2){cw[0][0][n][e0], cw[0][0][n][e0 + 1]}, w1 = (f32x2){cw[1][0][n][e0], cw[1][0][n][e0 + 1]}, w2 = (f32x2){cw[2][0][n][e0], cw[2][0][n][e0 + 1]};
                const f32x2 u0 = (f32x2){cw[0][1][n][e0], cw[0][1][n][e0 + 1]}, u1 = (f32x2){cw[1][1][n][e0], cw[1][1][n][e0 + 1]}, u2 = (f32x2){cw[2][1][n][e0], cw[2][1][n][e0 + 1]};
#pragma unroll
                for (int j = 0; j < 8; ++j) {
                    f32x2 x1 = j >= 1 ? g[j - 1] : gm1, x2 = j >= 2 ? g[j - 2] : (j == 1 ? gm1 : gm2);
                    f32x2 y1 = j >= 1 ? v[j - 1] : vm1, y2 = j >= 2 ? v[j - 2] : (j == 1 ? vm1 : vm2);
                    x1 = x1 * m1[j]; y1 = y1 * m1[j]; x2 = x2 * m2[j]; y2 = y2 * m2[j];
                    const f32x2 cg = w0 * x2 + w1 * x1 + w2 * g[j], cv = u0 * y2 + u1 * y1 + u2 * v[j];
                    f32x2 dn; dn.x = 1.0f + fexp(-cg.x); dn.y = 1.0f + fexp(-cg.y);
                    f32x2 rc; rc.x = __builtin_amdgcn_rcpf(dn.x); rc.y = __builtin_amdgcn_rcpf(dn.y);
                    const f32x2 a = cg * rc * cv;
                    outw[j][2 * n + ep] = cvt_pk_bf16(a.x, a.y); }
            }
    }
    template <class ACC> __device__ __forceinline__ void operator()(const ACC (&acc)[2][2][4][2], const Unit& u, int wr, int wc, int fr, int fq) const {
        const int tok0 = 254 * u.pm - 2 + 128 * wr + 8 * fr;
        const int jc = 128 * u.pn + 32 * wc + 8 * fq;
        f32x4 cw[3][2][2];
#pragma unroll
        for (int t = 0; t < 3; ++t)
#pragma unroll
            for (int gv = 0; gv < 2; ++gv)
#pragma unroll
                for (int n = 0; n < 2; ++n) cw[t][gv][n] = *(const f32x4*)(conv + t * 22016 + gv * 11008 + jc + 4 * n);
        float sa[8];
#pragma unroll
        for (int j = 0; j < 8; ++j) { const int t = tok0 + j; sa[j] = (I8 && t >= 0 && t < Mtok) ? sA[t] : 0.f; }
        PG8_LAS float* xs = xl + (wc * 4 + fq) * 32;
        if (wr == 0 && fr == 15) {
            f32x4 q[8];
#pragma unroll
            for (int n = 0; n < 2; ++n)
#pragma unroll
                for (int e = 0; e < 4; ++e) {
                    float g6 = (float)acc[1][0][2][n][e], g7 = (float)acc[1][0][3][n][e], v6 = (float)acc[1][1][2][n][e], v7 = (float)acc[1][1][3][n][e];
                    if (I8) { const float sg = sB[256 * u.pn + 32 * wc + 8 * fq + 4 * n + e], sv = sB[256 * u.pn + 128 + 32 * wc + 8 * fq + 4 * n + e]; g6 *= sa[6] * sg; g7 *= sa[7] * sg; v6 *= sa[6] * sv; v7 *= sa[7] * sv; }
                    q[n][e] = g6; q[2 + n][e] = g7; q[4 + n][e] = v6; q[6 + n][e] = v7; }
            const unsigned wa = (unsigned)(size_t)xs;
            asm volatile("ds_write_b128 %0, %1\n\tds_write_b128 %0, %2 offset:16\n\tds_write_b128 %0, %3 offset:32\n\tds_write_b128 %0, %4 offset:48\n\tds_write_b128 %0, %5 offset:64\n\tds_write_b128 %0, %6 offset:80\n\tds_write_b128 %0, %7 offset:96\n\tds_write_b128 %0, %8 offset:112\n\ts_waitcnt lgkmcnt(0)"
                         :: "v"(wa), "v"(q[0]), "v"(q[1]), "v"(q[2]), "v"(q[3]), "v"(q[4]), "v"(q[5]), "v"(q[6]), "v"(q[7]) : "memory");
        }
        asm volatile("s_waitcnt lgkmcnt(0)" ::: "memory"); __builtin_amdgcn_s_barrier(); asm volatile("" ::: "memory");
        const bool from_lds = (wr == 1 && fr == 0);
        float m1[8], m2[8];
#pragma unroll
        for (int j = 0; j < 8; ++j) { const int p = (tok0 + j) & 4095; m1[j] = p < 1 ? 0.f : 1.f; m2[j] = p < 2 ? 0.f : 1.f; }
        unsigned outw[8][4];
        body(acc, u, wc, fq, tok0, sa, from_lds, xs, cw, m1, m2, outw);
#pragma unroll
        for (int j = 0; j < 8; ++j) { const int t = tok0 + j; const bool ok = (t >= 0) && (t < Mtok) && !(wr == 0 && fr == 0 && j < 2);
            if (ok) { u32x4 w; w.x = outw[j][0]; w.y = outw[j][1]; w.z = outw[j][2]; w.w = outw[j][3]; *(u32x4*)(ACT + (size_t)t * 11008 + jc) = w; } }
    }
};

struct EpiNull {
    static constexpr bool PERM = true, AFTER_DRAIN = false; static constexpr int NSTORE = 0;
    template <class ACC> __device__ __forceinline__ void operator()(const ACC (&acc)[2][2][4][2], const Unit& u, int wr, int wc, int fr, int fq) const {
#pragma unroll
        for (int ai = 0; ai < 2; ++ai)
#pragma unroll
            for (int m = 0; m < 4; ++m)
#pragma unroll
                for (int bj = 0; bj < 2; ++bj) asm volatile("" :: "v"(acc[ai][bj][m][0]), "v"(acc[ai][bj][m][1]));
    }
};
struct EpiScratch {
    static constexpr bool PERM = true, AFTER_DRAIN = false; static constexpr int NSTORE = 0;
    unsigned char* ws; size_t off;
    template <class ACC> __device__ __forceinline__ void operator()(const ACC (&acc)[2][2][4][2], const Unit& u, int wr, int wc, int fr, int fq) const {
        const int row0 = wr * 64 + fr, col0 = wc * 32 + 8 * fq;
#ifdef PROBE_COAL
#ifdef PROBE_FRESH
        unsigned char* wb = ws + off + (size_t)(u.pn * 64 + u.pm) * 131072 + (size_t)__builtin_amdgcn_readfirstlane(wr * 4 + wc) * 16384;
#else
        unsigned char* wb = ws + off + (size_t)blockIdx.x * 131072 + (size_t)__builtin_amdgcn_readfirstlane(wr * 4 + wc) * 16384;
#endif
#ifdef PROBE_HALFWG
        const bool st_on = ((blockIdx.x >> 3) & 1) == 0;
#else
        const bool st_on = true;
#endif
        unsigned lo; asm volatile("v_mbcnt_lo_u32_b32 %0, -1, 0\n\tv_mbcnt_hi_u32_b32 %0, -1, %0\n\tv_lshlrev_b32 %0, 4, %0" : "=v"(lo));
        bf16_t* O = nullptr; (void)O;
#else
        bf16_t* O = (bf16_t*)(ws + off + (size_t)blockIdx.x * 131072) + row0 * 256 + col0;
#endif
#pragma unroll
        for (int ai = 0; ai < 2; ++ai)
#pragma unroll
#ifdef PROBE_COAL
            for (int m = 0; m < 4; ++m) { unsigned char* rowp = wb + (ai * 4 + m) * 2048;
#else
            for (int m = 0; m < 4; ++m) { bf16_t* rowp = O + (ai * HALF + m * 16) * 256;
#endif
#pragma unroll
                for (int bj = 0; bj < 2; ++bj) { f32x4 v0, v1;
#pragma unroll
                    for (int e = 0; e < 4; ++e) { v0[e] = (float)acc[ai][bj][m][0][e]; v1[e] = (float)acc[ai][bj][m][1][e]; }
                    u32x4 w; w.x = cvt_pk_bf16(v0[0], v0[1]); w.y = cvt_pk_bf16(v0[2], v0[3]); w.z = cvt_pk_bf16(v1[0], v1[1]); w.w = cvt_pk_bf16(v1[2], v1[3]);
#ifdef PROBE_HALF
                    if (ai == 0) *(u32x4*)(rowp + bj * 1024 + lo) = w; else asm volatile("" :: "v"(w)); } }
#elif defined(PROBE_COAL)
                    if (st_on) *(u32x4*)(rowp + bj * 1024 + lo) = w; else asm volatile("" :: "v"(w)); } }
#else
                    *(u32x4*)(rowp + bj * HALF) = w; } }
#endif
    }
};
template <bool I8, int FAKE = 0> struct EpiProj {
    static constexpr bool PERM = true, AFTER_DRAIN = false; static constexpr int NSTORE = (I8 && FAKE == 0) ? 16 : 0;
    unsigned char* ws; size_t o_qkva, o_z, o_qkvb, o_gates, o_bg, o_small, o_sa, o_sb;
    template <class ACC> __device__ __forceinline__ void operator()(const ACC (&acc)[2][2][4][2], const Unit& u, int wr, int wc, int fr, int fq) const {
        const int row0 = u.pm * BM + wr * 64 + fr;
        const int pn = u.pn;
        const float* small = (const float*)(ws + o_small);
        const float* sA = (const float*)(ws + o_sa); const float* sB = (const float*)(ws + o_sb) + pn * 256 + wc * 32 + 8 * fq;
        if (pn < 100) {
            float sa[2][4]; f32x4 s0[2], s1[2], b0[2], b1[2];
#pragma unroll
            for (int bj = 0; bj < 2; ++bj) { s0[bj] = (f32x4){1.f, 1.f, 1.f, 1.f}; s1[bj] = s0[bj]; b0[bj] = (f32x4){0.f, 0.f, 0.f, 0.f}; b1[bj] = b0[bj]; }
            if (I8) {
#pragma unroll
                for (int ai = 0; ai < 2; ++ai)
#pragma unroll
                    for (int m = 0; m < 4; ++m) sa[ai][m] = sA[row0 + ai * HALF + m * 16];
#pragma unroll
                for (int bj = 0; bj < 2; ++bj) { s0[bj] = *(const f32x4*)(sB + bj * HALF); s1[bj] = *(const f32x4*)(sB + bj * HALF + 4); }
            }
            const bool gate = pn >= 68;
            bf16_t* base; int ldc, colt;
            if (pn < 24) { base = (bf16_t*)(ws + o_qkva); ldc = 6144; colt = pn * 256; }
            else if (pn < 32) { base = (bf16_t*)(ws + o_z); ldc = 2048; colt = (pn - 24) * 256; }
            else if (pn < 68) { base = (bf16_t*)(ws + o_qkvb); ldc = 9216; colt = (pn - 32) * 256; }
            else { base = (bf16_t*)(ws + o_gates); ldc = 8192; colt = (pn - 68) * 256; }
            const int col0 = colt + wc * 32 + 8 * fq;
            if (gate) {
#pragma unroll
                for (int bj = 0; bj < 2; ++bj) { b0[bj] = *(const f32x4*)(small + col0 + bj * HALF); b1[bj] = *(const f32x4*)(small + col0 + bj * HALF + 4); }
            }
            if (I8) {
                asm volatile("" : "+v"(sa[0][0]), "+v"(sa[0][1]), "+v"(sa[0][2]), "+v"(sa[0][3]), "+v"(sa[1][0]), "+v"(sa[1][1]), "+v"(sa[1][2]), "+v"(sa[1][3]));
                asm volatile("" : "+v"(s0[0]), "+v"(s1[0]), "+v"(s0[1]), "+v"(s1[1]), "+v"(b0[0]), "+v"(b1[0]), "+v"(b0[1]), "+v"(b1[1]));
            }
#pragma unroll
            for (int bj = 0; bj < 2; ++bj) {
#pragma unroll
                for (int ai = 0; ai < 2; ++ai)
#pragma unroll
                    for (int m = 0; m < 4; ++m) { const int row = row0 + ai * HALF + m * 16; bf16_t* rowp = base + (size_t)row * ldc + col0 + bj * HALF;
                        if (FAKE == 1) rowp = (bf16_t*)(ws + o_qkva + (size_t)(u.pn * 64 + u.pm) * 131072 + (size_t)__builtin_amdgcn_readfirstlane(wr * 4 + wc) * 16384 + ((ai * 4 + m) * 2 + bj) * 1024 + (fq * 16 + fr) * 16);
                        f32x4 v0, v1;
#pragma unroll
                        for (int e = 0; e < 4; ++e) { v0[e] = (float)acc[ai][bj][m][0][e]; v1[e] = (float)acc[ai][bj][m][1][e]; }
                        if (I8) { const float a = sa[ai][m]; v0 = v0 * s0[bj] * a; v1 = v1 * s1[bj] * a; }
                        if (gate) { v0 = v0 + b0[bj]; v1 = v1 + b1[bj];
#pragma unroll
                            for (int j = 0; j < 4; ++j) { v0[j] = sigmoidf_(v0[j]); v1[j] = sigmoidf_(v1[j]); } }
                        u32x4 w; w.x = cvt_pk_bf16(v0[0], v0[1]); w.y = cvt_pk_bf16(v0[2], v0[3]); w.z = cvt_pk_bf16(v1[0], v1[1]); w.w = cvt_pk_bf16(v1[2], v1[3]);
                        *(u32x4*)rowp = w; }
            }
        } else {
            if (wc == 0) {
                float* bg = (float*)(ws + o_bg);
#pragma unroll
                for (int n = 0; n < 2; ++n) {
                    const int colb = 8 * fq + 4 * n;
                    float ea[4], db[4], sb[4];
#pragma unroll
                    for (int e = 0; e < 4; ++e) { const int hh = (colb + e) & 15; ea[e] = -fexp(small[8192 + hh]); db[e] = small[8192 + 16 + hh]; sb[e] = I8 ? sB[4 * n + e] : 1.f; }
#pragma unroll
                    for (int ai = 0; ai < 2; ++ai)
#pragma unroll
                        for (int m = 0; m < 4; ++m) { const int row = row0 + ai * HALF + m * 16; const float sa = I8 ? sA[row] : 1.f; f32x4 o;
#pragma unroll
                            for (int e = 0; e < 4; ++e) { const float v = (float)acc[ai][0][m][n][e] * (I8 ? sa * sb[e] : 1.f); o[e] = (colb < 16) ? sigmoidf_(v) : ea[e] * softplusf_(v + db[e]); }
                            *(f32x4*)(bg + (size_t)row * 32 + colb) = o; }
                }
            }
        }
    }
};

template <int MODE> struct EpiGated {
    static constexpr bool PERM = true, AFTER_DRAIN = false; static constexpr int NSTORE = 16;
    bf16_t* Tm; const bf16_t* gates; int goff; unsigned* rowmax;
    __device__ __forceinline__ void operator()(const f32x4 (&acc)[2][2][4][2], const Unit& u, int wr, int wc, int fr, int fq) const {
        const int row0 = u.pm * BM + wr * 64 + fr, col0 = u.pn * BM + wc * 32 + 8 * fq;
#pragma unroll
        for (int ai = 0; ai < 2; ++ai) {
            u32x4 g[4][2], t[4][2];
#pragma unroll
            for (int m = 0; m < 4; ++m) { const size_t row = (size_t)(row0 + ai * HALF + m * 16);
                const bf16_t* gp = gates + row * 8192 + goff + col0; const bf16_t* tp = Tm + row * 4096 + col0;
#pragma unroll
                for (int bj = 0; bj < 2; ++bj) { g[m][bj] = __builtin_nontemporal_load((const u32x4*)(gp + bj * HALF)); if (MODE == 1) t[m][bj] = *(const u32x4*)(tp + bj * HALF); } }
            float rm[4];
#pragma unroll
            for (int m = 0; m < 4; ++m) { const size_t row = (size_t)(row0 + ai * HALF + m * 16);
                bf16_t* rowp = Tm + row * 4096 + col0; float rmx = 0.f;
#pragma unroll
                for (int bj = 0; bj < 2; ++bj) { const f32x4 a0 = acc[ai][bj][m][0], a1 = acc[ai][bj][m][1]; const u32x4 gg = g[m][bj];
                    float r[8] = { bflo(gg.x) * a0[0], bfhi(gg.x) * a0[1], bflo(gg.y) * a0[2], bfhi(gg.y) * a0[3], bflo(gg.z) * a1[0], bfhi(gg.z) * a1[1], bflo(gg.w) * a1[2], bfhi(gg.w) * a1[3] };
                    if (MODE == 1) { const u32x4 tt = t[m][bj];
                        r[0] += bflo(tt.x); r[1] += bfhi(tt.x); r[2] += bflo(tt.y); r[3] += bfhi(tt.y); r[4] += bflo(tt.z); r[5] += bfhi(tt.z); r[6] += bflo(tt.w); r[7] += bfhi(tt.w);
#pragma unroll
                        for (int e = 0; e < 8; ++e) rmx = fmaxf(rmx, fabsf(r[e])); }
                    u32x4 w; w.x = cvt_pk_bf16(r[0], r[1]); w.y = cvt_pk_bf16(r[2], r[3]); w.z = cvt_pk_bf16(r[4], r[5]); w.w = cvt_pk_bf16(r[6], r[7]);
                    *(u32x4*)(rowp + bj * HALF) = w; }
                rm[m] = rmx; }
            if (MODE == 1 && rowmax) {
#pragma unroll
                for (int m = 0; m < 4; ++m) rm[m] = fmaxf(rm[m], __shfl_xor(rm[m], 16));
#pragma unroll
                for (int m = 0; m < 4; ++m) rm[m] = fmaxf(rm[m], __shfl_xor(rm[m], 32));
                if (fq == 0) {
#pragma unroll
                    for (int m = 0; m < 4; ++m) atomicMax(rowmax + (size_t)(row0 + ai * HALF + m * 16), __float_as_uint(rm[m] * 1.00390625f)); } }
            asm volatile("" ::: "memory"); }
    }
};

struct EpiGatedCat {
    static constexpr bool PERM = true, AFTER_DRAIN = false; static constexpr int NSTORE = 16;
    bf16_t* Tm; const bf16_t* gates; unsigned* rowmax;
    __device__ __forceinline__ void mid(f32x4 (&acc)[2][2][4][2], const Unit& u, int wr, int wc, int fr, int fq) const {
        asm volatile("" : "+v"(fr), "+v"(fq));
        const int row0 = u.pm * BM + wr * 64 + fr, col0 = u.pn * BM + wc * 32 + 8 * fq;
#pragma unroll
        for (int ai = 0; ai < 2; ++ai)
#pragma unroll
            for (int mh = 0; mh < 2; ++mh) {
                u32x4 ga[2][2], gb[2][2];
#pragma unroll
                for (int mm = 0; mm < 2; ++mm) { const bf16_t* gp = gates + (size_t)(row0 + ai * HALF + (2 * mh + mm) * 16) * 8192 + col0;
#pragma unroll
                    for (int bj = 0; bj < 2; ++bj) { ga[mm][bj] = *(const u32x4*)(gp + bj * HALF); gb[mm][bj] = *(const u32x4*)(gp + 4096 + bj * HALF); } }
#pragma unroll
                for (int mm = 0; mm < 2; ++mm)
#pragma unroll
                    for (int bj = 0; bj < 2; ++bj) { const u32x4 a = ga[mm][bj], b = gb[mm][bj]; const int m = 2 * mh + mm;
                        acc[ai][bj][m][0][0] *= bflo(a.x) * __builtin_amdgcn_rcpf(fmaxf(bflo(b.x), 1e-30f)); acc[ai][bj][m][0][1] *= bfhi(a.x) * __builtin_amdgcn_rcpf(fmaxf(bfhi(b.x), 1e-30f));
                        acc[ai][bj][m][0][2] *= bflo(a.y) * __builtin_amdgcn_rcpf(fmaxf(bflo(b.y), 1e-30f)); acc[ai][bj][m][0][3] *= bfhi(a.y) * __builtin_amdgcn_rcpf(fmaxf(bfhi(b.y), 1e-30f));
                        acc[ai][bj][m][1][0] *= bflo(a.z) * __builtin_amdgcn_rcpf(fmaxf(bflo(b.z), 1e-30f)); acc[ai][bj][m][1][1] *= bfhi(a.z) * __builtin_amdgcn_rcpf(fmaxf(bfhi(b.z), 1e-30f));
                        acc[ai][bj][m][1][2] *= bflo(a.w) * __builtin_amdgcn_rcpf(fmaxf(bflo(b.w), 1e-30f)); acc[ai][bj][m][1][3] *= bfhi(a.w) * __builtin_amdgcn_rcpf(fmaxf(bfhi(b.w), 1e-30f)); }
                asm volatile("" ::: "memory"); }
    }
    __device__ __forceinline__ void operator()(const f32x4 (&acc)[2][2][4][2], const Unit& u, int wr, int wc, int fr, int fq) const {
        asm volatile("" : "+v"(fr), "+v"(fq));
        const int row0 = u.pm * BM + wr * 64 + fr, col0 = u.pn * BM + wc * 32 + 8 * fq;
#pragma unroll
        for (int ai = 0; ai < 2; ++ai) {
            u32x4 g[4][2];
#pragma unroll
            for (int m = 0; m < 4; ++m) { const bf16_t* gp = gates + (size_t)(row0 + ai * HALF + m * 16) * 8192 + 4096 + col0;
#pragma unroll
                for (int bj = 0; bj < 2; ++bj) g[m][bj] = __builtin_nontemporal_load((const u32x4*)(gp + bj * HALF)); }
            float rm[4];
#pragma unroll
            for (int m = 0; m < 4; ++m) { bf16_t* rowp = Tm + (size_t)(row0 + ai * HALF + m * 16) * 4096 + col0; float rmx = 0.f;
#pragma unroll
                for (int bj = 0; bj < 2; ++bj) { const f32x4 a0 = acc[ai][bj][m][0], a1 = acc[ai][bj][m][1]; const u32x4 gg = g[m][bj];
                    const float bn[8] = { bflo(gg.x), bfhi(gg.x), bflo(gg.y), bfhi(gg.y), bflo(gg.z), bfhi(gg.z), bflo(gg.w), bfhi(gg.w) };
                    float r[8];
#pragma unroll
                    for (int e = 0; e < 4; ++e) { r[e] = fmaxf(bn[e], 1e-30f) * a0[e]; r[4 + e] = fmaxf(bn[4 + e], 1e-30f) * a1[e]; }
#pragma unroll
                    for (int e = 0; e < 8; ++e) rmx = fmaxf(rmx, fabsf(r[e]));
                    u32x4 w; w.x = cvt_pk_bf16(r[0], r[1]); w.y = cvt_pk_bf16(r[2], r[3]); w.z = cvt_pk_bf16(r[4], r[5]); w.w = cvt_pk_bf16(r[6], r[7]);
                    *(u32x4*)(rowp + bj * HALF) = w; }
                rm[m] = rmx; }
            if (rowmax) {
#pragma unroll
                for (int m = 0; m < 4; ++m) rm[m] = fmaxf(rm[m], __shfl_xor(rm[m], 16));
#pragma unroll
                for (int m = 0; m < 4; ++m) rm[m] = fmaxf(rm[m], __shfl_xor(rm[m], 32));
                if (fq == 0) {
#pragma unroll
                    for (int m = 0; m < 4; ++m) atomicMax(rowmax + (size_t)(row0 + ai * HALF + m * 16), __float_as_uint(rm[m] * 1.00390625f)); } }
            asm volatile("" ::: "memory"); }
    }
};

template <bool I8, int MODE> struct EpiResidP {
    static constexpr bool PERM = true, AFTER_DRAIN = false; static constexpr int NSTORE = MODE == 0 ? 16 : 32;
    const void* base; void* out; const float* gvec; const float* sA; const float* sB;
    template <class ACC> __device__ __forceinline__ void operator()(const ACC (&acc)[2][2][4][2], const Unit& u, int wr, int wc, int fr, int fq) const {
        const int row0 = u.pm * BM + wr * 64 + fr, col0 = u.pn * BM + wc * 32 + 8 * fq;
        const float* gv = gvec + (size_t)(u.pm >> 4) * 24576 + col0;
        f32x4 g0[2], g1[2], s0[2], s1[2];
#pragma unroll
        for (int bj = 0; bj < 2; ++bj) { g0[bj] = *(const f32x4*)(gv + bj * HALF); g1[bj] = *(const f32x4*)(gv + bj * HALF + 4);
            if (I8) { s0[bj] = *(const f32x4*)(sB + col0 + bj * HALF); s1[bj] = *(const f32x4*)(sB + col0 + bj * HALF + 4); } }
        asm volatile("" : "+v"(g0[0]), "+v"(g1[0]), "+v"(g0[1]), "+v"(g1[1]));
        if (I8) { asm volatile("" : "+v"(s0[0]), "+v"(s1[0]), "+v"(s0[1]), "+v"(s1[1]));
#pragma unroll
            for (int bj = 0; bj < 2; ++bj) { g0[bj] = g0[bj] * s0[bj]; g1[bj] = g1[bj] * s1[bj]; } }
#pragma unroll
        for (int ai = 0; ai < 2; ++ai) {
            f32x4 b0[4][2], b1[4][2]; u32x4 bb[4][2]; float sa[4];
#pragma unroll
            for (int m = 0; m < 4; ++m) { const int row = row0 + ai * HALF + m * 16; const size_t off = (size_t)row * 4096 + col0; sa[m] = I8 ? sA[row] : 1.f;
#pragma unroll
                for (int bj = 0; bj < 2; ++bj) {
                    if (MODE == 0) { b0[m][bj] = __builtin_nontemporal_load((const f32x4*)((const float*)base + off + bj * HALF)); b1[m][bj] = __builtin_nontemporal_load((const f32x4*)((const float*)base + off + bj * HALF + 4)); }
                    else bb[m][bj] = __builtin_nontemporal_load((const u32x4*)((const bf16_t*)base + off + bj * HALF)); } }
#pragma unroll
            for (int m = 0; m < 4; ++m) { const int row = row0 + ai * HALF + m * 16; const size_t off = (size_t)row * 4096 + col0;
#pragma unroll
                for (int bj = 0; bj < 2; ++bj) { f32x4 v0, v1;
#pragma unroll
                    for (int e = 0; e < 4; ++e) { v0[e] = (float)acc[ai][bj][m][0][e]; v1[e] = (float)acc[ai][bj][m][1][e]; }
                    if (I8) { v0 = v0 * sa[m]; v1 = v1 * sa[m]; }
                    if (MODE == 0) { const f32x4 r0 = b0[m][bj] + g0[bj] * v0, r1 = b1[m][bj] + g1[bj] * v1;
                        u32x4 w; w.x = cvt_pk_bf16(r0[0], r0[1]); w.y = cvt_pk_bf16(r0[2], r0[3]); w.z = cvt_pk_bf16(r1[0], r1[1]); w.w = cvt_pk_bf16(r1[2], r1[3]);
                        *(u32x4*)((bf16_t*)out + off + bj * HALF) = w; }
                    else { const u32x4 t = bb[m][bj];
                        const f32x4 x0 = (f32x4){bflo(t.x), bfhi(t.x), bflo(t.y), bfhi(t.y)}, x1 = (f32x4){bflo(t.z), bfhi(t.z), bflo(t.w), bfhi(t.w)};
                        *(f32x4*)((float*)out + off + bj * HALF) = x0 + g0[bj] * v0; *(f32x4*)((float*)out + off + bj * HALF + 4) = x1 + g1[bj] * v1; } } }
            asm volatile("" ::: "memory"); }
    }
};

template <bool I8> struct EpiResid {
    static constexpr bool PERM = false, AFTER_DRAIN = false; static constexpr int NSTORE = 32;
    const float* base; float* out; const float* gvec; const float* sA; const float* sB;
    template <class ACC> __device__ __forceinline__ void operator()(const ACC (&acc)[2][2][4][2], const Unit& u, int wr, int wc, int fr, int fq) const {
        const int row0 = u.pm * BM + wr * 64 + fr, col0 = u.pn * BM + wc * 32 + 4 * fq;
        const float* gv = gvec + (size_t)(u.pm >> 4) * 24576 + col0;
        f32x4 gm[2][2], sb[2][2];
#pragma unroll
        for (int bj = 0; bj < 2; ++bj)
#pragma unroll
            for (int n = 0; n < 2; ++n) { gm[bj][n] = *(const f32x4*)(gv + bj * HALF + n * 16); if (I8) sb[bj][n] = *(const f32x4*)(sB + col0 + bj * HALF + n * 16); }
        asm volatile("" : "+v"(gm[0][0]), "+v"(gm[0][1]), "+v"(gm[1][0]), "+v"(gm[1][1]));
        if (I8) { asm volatile("" : "+v"(sb[0][0]), "+v"(sb[0][1]), "+v"(sb[1][0]), "+v"(sb[1][1]));
#pragma unroll
            for (int bj = 0; bj < 2; ++bj)
#pragma unroll
                for (int n = 0; n < 2; ++n) gm[bj][n] = gm[bj][n] * sb[bj][n]; }
#pragma unroll
        for (int ai = 0; ai < 2; ++ai) {
            f32x4 bs[4][2][2]; float sa[4];
#pragma unroll
            for (int m = 0; m < 4; ++m) { const int row = row0 + ai * HALF + m * 16; const size_t off = (size_t)row * 4096 + col0; sa[m] = I8 ? sA[row] : 1.f;
#pragma unroll
                for (int bj = 0; bj < 2; ++bj)
#pragma unroll
                    for (int n = 0; n < 2; ++n) bs[m][bj][n] = __builtin_nontemporal_load((const f32x4*)(base + off + bj * HALF + n * 16)); }
#pragma unroll
            for (int m = 0; m < 4; ++m) { const int row = row0 + ai * HALF + m * 16; const size_t off = (size_t)row * 4096 + col0;
#pragma unroll
                for (int bj = 0; bj < 2; ++bj)
#pragma unroll
                    for (int n = 0; n < 2; ++n) { f32x4 av;
#pragma unroll
                        for (int e = 0; e < 4; ++e) av[e] = (float)acc[ai][bj][m][n][e];
                        if (I8) av = av * sa[m];
                        *(f32x4*)(out + off + bj * HALF + n * 16) = bs[m][bj][n] + gm[bj][n] * av; } }
            asm volatile("" ::: "memory"); }
    }
};
template <class Epi, class Sched, bool ALIGN_EPI = false, bool SP2 = false, class AMap = AMapNat, class MMA = MmaBf16, int KMID = 0>
__device__ __forceinline__ void gemm_phase(PG8_LAS unsigned char* lds, const Gemm g, const Sched& S, const Epi& E) {
    const int tid = threadIdx.x, wid = __builtin_amdgcn_readfirstlane(tid >> 6), lane = tid & 63, wr = wid >> 2, wc = wid & 3, fr = lane & 15, fq = lane >> 4;
    const int K = g.K, nt = K / BK;
    int voffA[2]; unsigned voffB[2];
#pragma unroll
    for (int i = 0; i < 2; ++i) { int R, C; stage_rc(tid * 16 + i * 8192, R, C); const int Rb = Epi::PERM ? ((R & ~31) + perm32(R & 31)) : R;
        voffA[i] = AMap::voff(R, C, K); voffB[i] = (unsigned)(Rb * K + C) * 2u; }
    const size_t kstep = (size_t)(BK * 2);
    const size_t hstepB = (size_t)HALF * K * 2, tstepB = 2 * hstepB;
    const size_t hstepA = AMap::hstep(K), tstepA = AMap::tstep(K);
    const unsigned ldsw = (unsigned)wid * 1024u;
    const int aoff = lds_byte(wr * 64 + fr, fq * 8), boff = lds_byte(wc * 32 + fr, fq * 8);
#define PG8_SA(b, h) (((b) * 2 + (h)) * HTB)
#define PG8_SB(b, h) ((4 + (b) * 2 + (h)) * HTB)
#define PG8_STAGE(bufoff, gbase, voff) do { _Pragma("unroll") for (int _i = 0; _i < 2; ++_i) \
        __builtin_amdgcn_global_load_lds((const unsigned*)((const char*)(gbase) + (voff)[_i]), (PG8_LAS unsigned*)(lds + (bufoff) + ldsw + _i * 8192), 16, 0, 0); } while (0)
#define PG8_LDA(dst, b, h) do { _Pragma("unroll") for (int m = 0; m < 4; ++m) _Pragma("unroll") for (int k = 0; k < 2; ++k) dst[m][k] = *(const PG8_LAS bf16x8*)(lds + PG8_SA(b, h) + aoff + m * 2048 + k * 1024); } while (0)
#define PG8_LDB(dst, b, h) do { _Pragma("unroll") for (int n = 0; n < 2; ++n) _Pragma("unroll") for (int k = 0; k < 2; ++k) dst[n][k] = *(const PG8_LAS bf16x8*)(lds + PG8_SB(b, h) + boff + n * 2048 + k * 1024); } while (0)
#define PG8_MMA(ai, bj, At, Bt) do { __builtin_amdgcn_s_setprio(1); _Pragma("unroll") for (int m = 0; m < 4; ++m) _Pragma("unroll") for (int n = 0; n < 2; ++n) _Pragma("unroll") for (int k = 0; k < 2; ++k) \
        acc[ai][bj][m][n] = MMA::mma(Bt[n][k], At[m][k], acc[ai][bj][m][n]); __builtin_amdgcn_s_setprio(0); } while (0)
#define PG8_WAIT_V(n) asm volatile("s_waitcnt vmcnt(" #n ")" ::: "memory")
#define PG8_WAIT_L(n) asm volatile("s_waitcnt lgkmcnt(" #n ")" ::: "memory")
#define PG8_WAIT_V8R(rl) asm volatile("s_cmp_eq_u32 %0, 0\n\ts_cbranch_scc1 1f\n\ts_waitcnt vmcnt(%1)\n\ts_branch 2f\n1:\n\ts_waitcnt vmcnt(8)\n2:" :: "s"(rl), "n"(8 + Epi::NSTORE) : "memory", "scc")
#define PG8_BAR __builtin_amdgcn_s_barrier()
#define PG8_SCHED __builtin_amdgcn_sched_barrier(0)
    Unit cur, nxt; int ui = 0; bool rlx = false;
    if (!S.next(0, cur)) return;
    typename MMA::acc_t acc[2][2][4][2];
#pragma unroll
    for (int a = 0; a < 2; ++a)
#pragma unroll
        for (int b = 0; b < 2; ++b)
#pragma unroll
            for (int m = 0; m < 4; ++m)
#pragma unroll
                for (int n = 0; n < 2; ++n) acc[a][b][m][n] = MMA::zero();
    bf16x8 At[4][2], B0[2][2], B1[2][2];
    const char* cA = (const char*)g.A + (size_t)cur.pm * tstepA; const char* cB = (const char*)g.Bt + (size_t)cur.pn * tstepB;
    S.a_ready(cur);
    if constexpr (SP2) {
        PG8_STAGE(PG8_SB(0, 0), cB, voffB); PG8_STAGE(PG8_SB(0, 1), cB + hstepB, voffB); PG8_STAGE(PG8_SA(0, 0), cA, voffA); PG8_STAGE(PG8_SA(0, 1), cA + hstepA, voffA);
        if (wr == 1) PG8_BAR;
        PG8_WAIT_V(2); PG8_BAR;
        PG8_STAGE(PG8_SB(1, 0), cB + kstep, voffB); PG8_STAGE(PG8_SA(1, 0), cA + kstep, voffA); PG8_STAGE(PG8_SB(1, 1), cB + hstepB + kstep, voffB);
        PG8_WAIT_V(6); PG8_BAR;
    } else {
        PG8_STAGE(PG8_SB(0, 0), cB, voffB); PG8_STAGE(PG8_SA(0, 0), cA, voffA); PG8_STAGE(PG8_SB(0, 1), cB + hstepB, voffB); PG8_STAGE(PG8_SA(0, 1), cA + hstepA, voffA);
        if (wr == 1) PG8_BAR;
        PG8_WAIT_V(4); PG8_BAR;
        PG8_STAGE(PG8_SB(1, 0), cB + kstep, voffB); PG8_STAGE(PG8_SA(1, 0), cA + kstep, voffA); PG8_STAGE(PG8_SB(1, 1), cB + hstepB + kstep, voffB);
        PG8_WAIT_V(6); PG8_BAR;
    }
    for (;;) {
        const bool has_next = S.next(ui + 1, nxt);
        const char* nA = has_next ? (const char*)g.A + (size_t)nxt.pm * tstepA : cA; const char* nB = has_next ? (const char*)g.Bt + (size_t)nxt.pn * tstepB : cB;
        _Pragma("unroll") for (int seg = 0; seg < (KMID ? 2 : 1); ++seg) {
        const int tA = seg ? KMID : 0, tB = (KMID && seg == 0) ? KMID : nt;
        for (int t = tA; t < tB; t += 2) {
            const bool last = (t == nt - 2);
            const char* a1 = cA + (size_t)(t + 1) * kstep;
            const char* a2 = last ? nA : cA + (size_t)(t + 2) * kstep; const char* b2 = last ? nB : cB + (size_t)(t + 2) * kstep;
            const char* a3 = a2 + kstep; const char* b3 = b2 + kstep;
            if (last && has_next) S.a_ready(nxt);
            if constexpr (SP2) {
            const int rl = __builtin_amdgcn_readfirstlane((rlx && t == 0) ? 1 : 0);
            PG8_LDB(B0, 0, 0); PG8_LDB(B1, 0, 1); PG8_SCHED; PG8_LDA(At, 0, 0); PG8_STAGE(PG8_SA(1, 1), a1 + hstepA, voffA);
            PG8_WAIT_V8R(rl); PG8_WAIT_L(0); PG8_BAR; PG8_MMA(0, 0, At, B0); PG8_MMA(0, 1, At, B1); PG8_BAR; PG8_SCHED;
            PG8_LDA(At, 0, 1); PG8_STAGE(PG8_SB(0, 0), b2, voffB); PG8_STAGE(PG8_SB(0, 1), b2 + hstepB, voffB); PG8_STAGE(PG8_SA(0, 0), a2, voffA);
            PG8_WAIT_V8R(rl); PG8_WAIT_L(0); PG8_BAR; PG8_MMA(1, 0, At, B0); PG8_MMA(1, 1, At, B1); PG8_BAR; PG8_SCHED;
            PG8_LDB(B0, 1, 0); PG8_LDB(B1, 1, 1); PG8_SCHED; PG8_LDA(At, 1, 0); PG8_STAGE(PG8_SA(0, 1), a2 + hstepA, voffA);
            PG8_WAIT_V(8); PG8_WAIT_L(0); PG8_BAR; PG8_MMA(0, 0, At, B0); PG8_MMA(0, 1, At, B1); PG8_BAR; PG8_SCHED;
            PG8_LDA(At, 1, 1); PG8_STAGE(PG8_SB(1, 0), b3, voffB); PG8_STAGE(PG8_SB(1, 1), b3 + hstepB, voffB); PG8_STAGE(PG8_SA(1, 0), a3, voffA);
            PG8_WAIT_V(8); PG8_WAIT_L(0); PG8_BAR; PG8_MMA(1, 0, At, B0); PG8_MMA(1, 1, At, B1); PG8_BAR; PG8_SCHED;
            } else {
            PG8_LDB(B0, 0, 0); PG8_SCHED; PG8_LDA(At, 0, 0); PG8_STAGE(PG8_SA(1, 1), a1 + hstepA, voffA);
            PG8_WAIT_L(8); PG8_BAR; PG8_WAIT_L(0); PG8_MMA(0, 0, At, B0); PG8_BAR; PG8_SCHED;
            PG8_LDB(B1, 0, 1); PG8_STAGE(PG8_SB(0, 0), b2, voffB);
            PG8_BAR; PG8_WAIT_L(0); PG8_MMA(0, 1, At, B1); PG8_BAR;
            PG8_LDA(At, 0, 1); PG8_STAGE(PG8_SA(0, 0), a2, voffA);
            PG8_BAR; PG8_WAIT_L(0); PG8_MMA(1, 0, At, B0); PG8_BAR; PG8_SCHED;
            PG8_STAGE(PG8_SB(0, 1), b2 + hstepB, voffB);
            PG8_WAIT_V(6); PG8_BAR; PG8_MMA(1, 1, At, B1); PG8_BAR;
            PG8_LDB(B0, 1, 0); PG8_SCHED; PG8_LDA(At, 1, 0); PG8_STAGE(PG8_SA(0, 1), a2 + hstepA, voffA);
            PG8_WAIT_L(8); PG8_BAR; PG8_WAIT_L(0); PG8_MMA(0, 0, At, B0); PG8_BAR; PG8_SCHED;
            PG8_LDB(B1, 1, 1); PG8_STAGE(PG8_SB(1, 0), b3, voffB);
            PG8_BAR; PG8_WAIT_L(0); PG8_MMA(0, 1, At, B1); PG8_BAR;
            PG8_LDA(At, 1, 1); PG8_STAGE(PG8_SA(1, 0), a3, voffA);
            PG8_BAR; PG8_WAIT_L(0); PG8_MMA(1, 0, At, B0); PG8_BAR; PG8_SCHED;
            PG8_STAGE(PG8_SB(1, 1), b3 + hstepB, voffB);
            PG8_WAIT_V(6); PG8_BAR; PG8_MMA(1, 1, At, B1); PG8_BAR;
            }
        }
        if constexpr (KMID != 0) { if (seg == 0) E.mid(acc, cur, wr, wc, fr, fq); }
        }
        if constexpr (ALIGN_EPI) { if (wr == 0) PG8_BAR; }
        if constexpr (!Epi::AFTER_DRAIN) { E(acc, cur, wr, wc, fr, fq); S.done(cur); rlx = (Epi::NSTORE > 0); }
        if (!has_next) break;
#pragma unroll
        for (int a = 0; a < 2; ++a)
#pragma unroll
            for (int b = 0; b < 2; ++b)
#pragma unroll
                for (int m = 0; m < 4; ++m)
#pragma unroll
                    for (int n = 0; n < 2; ++n) acc[a][b][m][n] = MMA::zero();
        cur = nxt; cA = nA; cB = nB; ++ui;
        if constexpr (ALIGN_EPI) { if (wr == 1) PG8_BAR; }
    }
    PG8_WAIT_V(0);
    if constexpr (!ALIGN_EPI) { if (wr == 0) PG8_BAR; }
    PG8_BAR;
    if constexpr (Epi::AFTER_DRAIN) { E.fused(acc, cur, wr, wc, fr, fq, lds, wid, lane); S.done(cur); }
#undef PG8_SA
#undef PG8_SB
#undef PG8_STAGE
#undef PG8_LDA
#undef PG8_LDB
#undef PG8_MMA
#undef PG8_WAIT_V
#undef PG8_WAIT_L
#undef PG8_WAIT_V8R
#undef PG8_BAR
#undef PG8_SCHED
}
}

#define LAS __attribute__((address_space(3)))
typedef unsigned short bf16;
typedef short bf16x8 __attribute__((ext_vector_type(8)));
typedef float f32x4 __attribute__((ext_vector_type(4)));
typedef unsigned u32x4 __attribute__((ext_vector_type(4)));
typedef unsigned u32x2 __attribute__((ext_vector_type(2)));

constexpr int NWAVES = 8, NTHR = 512;
constexpr int D = 4096, NBATCH = 4, T = 4096, M = NBATCH * T;
constexpr int N_IN = 25632, N_IN_PAD = 25856, DFF = 11008, NMOD = 6 * D;
constexpr float EPS = 1e-6f;
constexpr int N_PHASES = 13;

constexpr size_t MiB = 1u << 20;
#ifndef I8_PROJ
#define I8_PROJ 1
#endif
#ifndef I8_O
#define I8_O 1
#endif
#ifndef CATAB
#define CATAB 1
#endif
#ifndef X1B
#define X1B 1
#endif
#ifndef I8_UP
#define I8_UP 0
#endif
constexpr size_t WS_CTL = 0, CTL_ZERO_BYTES = 352256, WS_CM_IN = 65536, WS_CM_UP = 65536 + 106496, WS_CM_O = 262144, WS_RM_O = 262144 + 16384;
constexpr size_t WS_MOD = 1 * MiB, WS_DEC = 1 * MiB + 512 * 1024, WS_SMALL = 1 * MiB + 768 * 1024;
constexpr size_t WS_BT_A = 2 * MiB, WS_BT_B = 18 * MiB, WS_BT_O = 26 * MiB, WS_BT_UP = 58 * MiB, WS_BT_DN = 230 * MiB;
constexpr size_t WS_RA = 316 * MiB;
constexpr size_t WS_BT_IN = WS_RA, WS_H = WS_RA + 202 * MiB;
constexpr size_t WS_D1 = WS_RA;
constexpr size_t WS_TM = WS_RA;
constexpr size_t WS_H2 = WS_RA;
constexpr size_t WS_RB = 662 * MiB;
constexpr size_t WS_QKVA = WS_RB, WS_Z = WS_RB + 192 * MiB, WS_QKVB = WS_RB + 256 * MiB, WS_GATES = WS_RB + 544 * MiB, WS_BG = WS_RB + 800 * MiB;
constexpr size_t WS_ACT = WS_RB;
constexpr size_t WS_OAN = WS_RB, WS_OB = WS_RB + 64 * MiB;
constexpr size_t WS_RC = 1464 * MiB;
constexpr size_t WS_SWAO = WS_RC, WS_LSE = WS_RC + 96 * MiB, WS_OA = WS_RC + 98 * MiB;
constexpr size_t WS_X1B = WS_RC;
constexpr size_t WS_ROPE = 1626 * MiB;
constexpr size_t WS_SA_IN = 1628 * MiB, WS_SB_IN = WS_SA_IN + 65536, WS_SA_UP = WS_SB_IN + 106496, WS_SB_UP = WS_SA_UP + 65536;
constexpr size_t WS_SA_O = WS_SB_UP + 90112, WS_SB_O = WS_SA_O + 65536;
constexpr size_t WS_TMQ = WS_RA + 128 * MiB;
constexpr size_t WS_END = 1629 * MiB;
constexpr size_t D1_CHUNK_BYTES = 73728;
constexpr int CW_BAR = 1024;

constexpr int LDS_BYTES = 147456;
constexpr int XL_OFF = 131072;
constexpr int MISC_OFF = 147456 - 256;

#define LDS_WAIT() asm volatile("s_waitcnt lgkmcnt(0)" ::: "memory")
#define VM_WAIT() asm volatile("s_waitcnt vmcnt(0)" ::: "memory")
typedef __bf16 bf16x2_t __attribute__((ext_vector_type(2)));
typedef float f32x2_t __attribute__((ext_vector_type(2)));
__device__ __forceinline__ unsigned pk2(float lo, float hi) { const f32x2_t v = {lo, hi}; const bf16x2_t b = __builtin_convertvector(v, bf16x2_t); return __builtin_bit_cast(unsigned, b); }
__device__ __forceinline__ unsigned f2bf(float f) { return pk2(f, f) & 0xffffu; }
__device__ __forceinline__ float bflo(unsigned w) { return __uint_as_float(w << 16); }
__device__ __forceinline__ float bfhi(unsigned w) { return __uint_as_float(w & 0xffff0000u); }
__device__ __forceinline__ float fexp(float x) { return __builtin_amdgcn_exp2f(x * 1.4426950408889634f); }
__device__ __forceinline__ float silu_(float x) { return x * __builtin_amdgcn_rcpf(1.0f + fexp(-x)); }
__device__ __forceinline__ float wave_sum(float v) {
#pragma unroll
    for (int o = 1; o < 64; o <<= 1) v += __shfl_xor(v, o);
    return v;
}
__device__ __forceinline__ void unpack8(const u32x4 r, float (&f)[8]) { f[0] = bflo(r.x); f[1] = bfhi(r.x); f[2] = bflo(r.y); f[3] = bfhi(r.y); f[4] = bflo(r.z); f[5] = bfhi(r.z); f[6] = bflo(r.w); f[7] = bfhi(r.w); }
__device__ __forceinline__ u32x4 pack8(const float (&f)[8]) { u32x4 w; w.x = pk2(f[0], f[1]); w.y = pk2(f[2], f[3]); w.z = pk2(f[4], f[5]); w.w = pk2(f[6], f[7]); return w; }
__device__ __forceinline__ bf16x8 ldfrag(const LAS unsigned char* base, int stride, int row0, int k0, int lane) {
    return *(const LAS bf16x8*)(base + (row0 + (lane & 15)) * stride + (k0 + 8 * (lane >> 4)) * 2);
}
#define MFMA16(a, b, c) __builtin_amdgcn_mfma_f32_16x16x32_bf16((a), (b), (c), 0, 0, 0)

#define XB_TMO      128
#define XB_XCNT(j)  (256  + 64 * (j))
#define XB_XSUB(j)  (1280 + 64 * (j))
#define XB_XGEN(j)  (2304 + 64 * (j))
#define XB_TOP      3328
#define XB_TOPGEN   3392
#define XCD_BAR_WORDS 3456
#define XB_SPIN_CAP (1u << 18)
__device__ __forceinline__ unsigned xb_ld(unsigned* p)              { return __hip_atomic_load(p, __ATOMIC_RELAXED, __HIP_MEMORY_SCOPE_AGENT); }
__device__ __forceinline__ unsigned xb_add(unsigned* p, unsigned v) { return __hip_atomic_fetch_add(p, v, __ATOMIC_RELAXED, __HIP_MEMORY_SCOPE_AGENT); }
__device__ __forceinline__ unsigned xb_xcc_id() { return (unsigned)__builtin_amdgcn_s_getreg((3 << 11) | 20) & 0xFu; }
#define XB_SPIN(cond, bar) do { unsigned _sp = 0; while (cond) { __builtin_amdgcn_s_sleep(1); \
    if ((++_sp & 255u) == 0u) { if (xb_ld(&(bar)[XB_TMO])) break; if (_sp > XB_SPIN_CAP) { atomicAdd(&(bar)[XB_TMO], 1u); break; } } } } while (0)
struct XcdBarrier { unsigned* bar; unsigned x; volatile LAS unsigned* st; };
__device__ __forceinline__ XcdBarrier xcd_barrier_post(unsigned* bar, volatile LAS unsigned* st) {
    XcdBarrier b; b.bar = bar; b.x = xb_xcc_id(); b.st = st;
    if (threadIdx.x == 0) (void)xb_add(&bar[XB_XCNT(b.x)], 1u);
    return b;
}
__device__ __forceinline__ void xcd_barrier_complete(unsigned* bar, unsigned x, unsigned& nloc, unsigned& nx) {
    const unsigned G = gridDim.x * gridDim.y * gridDim.z;
    unsigned sum, cnt, mine, sp = 0u;
    for (;;) {
        sum = 0u; cnt = 0u; mine = 0u;
#pragma unroll
        for (unsigned j = 0; j < 16; ++j) { const unsigned c = xb_ld(&bar[XB_XCNT(j)]); sum += c; cnt += (c > 0u) ? 1u : 0u; mine = (j == x) ? c : mine; }
        if (sum == G) break;
        __builtin_amdgcn_s_sleep(1);
        if ((++sp & 255u) == 0u) { if (xb_ld(&bar[XB_TMO])) break; if (sp > XB_SPIN_CAP) { atomicAdd(&bar[XB_TMO], 1u); break; } }
    }
    nloc = mine > 0u ? mine : 1u; nx = cnt > 0u ? cnt : 1u;
}
__device__ __forceinline__ void xcd_barrier(const XcdBarrier& b) {
    asm volatile("s_waitcnt vmcnt(0)" ::: "memory");
    __syncthreads();
    if (threadIdx.x == 0) {
        unsigned* bar = b.bar;
        __builtin_amdgcn_s_waitcnt(0);
        unsigned nloc = b.st[0], nx = b.st[1];
        if (nloc == 0u) { xcd_barrier_complete(bar, b.x, nloc, nx); b.st[0] = nloc; b.st[1] = nx; }
        const unsigned old = xb_add(&bar[XB_XSUB(b.x)], 1u);
        const unsigned gen = old / nloc;
        if (old + 1u == (gen + 1u) * nloc) {
            __builtin_amdgcn_fence(__ATOMIC_RELEASE, "agent");
            asm volatile("s_waitcnt vmcnt(0)" ::: "memory");
            const unsigned og = xb_add(&bar[XB_TOP], 1u);
            const unsigned tg = og / nx;
            if (og + 1u == (tg + 1u) * nx) xb_add(&bar[XB_TOPGEN], 1u);
            else XB_SPIN(xb_ld(&bar[XB_TOPGEN]) == tg, bar);
            __builtin_amdgcn_fence(__ATOMIC_ACQUIRE, "agent");
            xb_add(&bar[XB_XGEN(b.x)], 1u);
            asm volatile("s_waitcnt vmcnt(0)" ::: "memory");
        } else {
            XB_SPIN(xb_ld(&bar[XB_XGEN(b.x)]) == gen, bar);
            __builtin_amdgcn_fence(__ATOMIC_ACQUIRE, "agent");
            asm volatile("s_waitcnt vmcnt(0)" ::: "memory");
        }
    }
    __syncthreads();
}

struct Frame {
    LAS unsigned char* lds;
    int tid, lane, wave, vcu, G;
    float* out;
    unsigned char* ws;
};
enum { I_X = 0, I_C, I_POS, I_WADA, I_BADA, I_WIN, I_BGATE, I_CONVQKV, I_ALOG, I_DTBIAS, I_OGAIN, I_WA, I_QGAIN, I_KGAIN, I_WB, I_WO, I_WUP, I_CONVFFN, I_WDOWN };
template <int IDX> __device__ __forceinline__ const float* karg() {
    unsigned long long p; asm volatile("s_load_dwordx2 %0, %1, %2\n\ts_waitcnt lgkmcnt(0)" : "=s"(p) : "s"(__builtin_amdgcn_kernarg_segment_ptr()), "i"(8 * IDX) : "memory");
    const float* q = (const float*)(const __attribute__((address_space(1))) float*)p;
    return q;
}
#define WSP(T_, off) ((T_*)(F.ws + (off)))

__device__ __forceinline__ unsigned q8x4(float a, float b, float c, float d, float s) {
    const int q0 = (int)__builtin_rintf(a * s), q1 = (int)__builtin_rintf(b * s), q2 = (int)__builtin_rintf(c * s), q3 = (int)__builtin_rintf(d * s);
    return (unsigned)(q0 & 255) | ((unsigned)(q1 & 255) << 8) | ((unsigned)(q2 & 255) << 16) | ((unsigned)q3 << 24);
}
template <int OUT, bool UPIL, bool NTST = false> __device__ __forceinline__ void transpose_item(const float* __restrict__ W, int ldw, int src_col0, int nblk, void* WTv, int K, int dst_row0, LAS float* scr, int item, int lane, unsigned* colmax = nullptr, float* sB = nullptr) {
    const int kb = item / nblk, nb = item - kb * nblk, k0 = 64 * kb, n0 = 32 * nb;
    { const int r8 = lane >> 3, c4 = lane & 7;
      const float* src = W + (size_t)(k0 + r8) * ldw + src_col0 + n0 + 4 * c4;
      f32x4 t[8];
#pragma unroll
      for (int i = 0; i < 8; ++i) t[i] = __builtin_nontemporal_load((const f32x4*)(src + (size_t)(8 * i) * ldw));
#pragma unroll
      for (int i = 0; i < 8; ++i) { LAS float* d = scr + (8 * i + r8) * 33 + 4 * c4; d[0] = t[i].x; d[1] = t[i].y; d[2] = t[i].z; d[3] = t[i].w; } }
    LDS_WAIT();
    int drow0 = dst_row0 + n0;
    if (UPIL) { const int isv = n0 >= DFF, n1 = isv ? n0 - DFF : n0; drow0 = 256 * (n1 >> 7) + 128 * isv + (n1 & 127); }
    if (OUT == 1) {
        float m = 0.f; const LAS float* sp = scr + (32 * (lane >> 5)) * 33 + (lane & 31);
#pragma unroll
        for (int kk = 0; kk < 32; ++kk) m = fmaxf(m, fabsf(sp[kk * 33]));
        m = fmaxf(m, __shfl_xor(m, 32));
        if (lane < 32) atomicMax(colmax + drow0 + lane, __float_as_uint(m));
    } else if (OUT == 2) {
        const int n = lane >> 1, half = lane & 1, row = drow0 + n;
        const float cm = __uint_as_float(colmax[row]), inv = cm > 0.f ? 127.0f / cm : 0.f;
        if (kb == 0 && half == 0) sB[row] = cm * (1.0f / 127.0f);
        const LAS float* sp = scr + (32 * half) * 33 + n;
        u32x4 w0, w1;
        w0.x = q8x4(sp[0 * 33], sp[1 * 33], sp[2 * 33], sp[3 * 33], inv); w0.y = q8x4(sp[4 * 33], sp[5 * 33], sp[6 * 33], sp[7 * 33], inv); w0.z = q8x4(sp[8 * 33], sp[9 * 33], sp[10 * 33], sp[11 * 33], inv); w0.w = q8x4(sp[12 * 33], sp[13 * 33], sp[14 * 33], sp[15 * 33], inv);
        w1.x = q8x4(sp[16 * 33], sp[17 * 33], sp[18 * 33], sp[19 * 33], inv); w1.y = q8x4(sp[20 * 33], sp[21 * 33], sp[22 * 33], sp[23 * 33], inv); w1.z = q8x4(sp[24 * 33], sp[25 * 33], sp[26 * 33], sp[27 * 33], inv); w1.w = q8x4(sp[28 * 33], sp[29 * 33], sp[30 * 33], sp[31 * 33], inv);
        u32x4* dst = (u32x4*)((unsigned char*)WTv + (size_t)row * K + k0 + 32 * half);
        dst[0] = w0; dst[1] = w1;
    } else {
        bf16* WT = (bf16*)WTv; const int c = lane & 7;
#pragma unroll
        for (int j = 0; j < 4; ++j) { const int n = (lane >> 3) + 8 * j; const LAS float* s = scr + (8 * c) * 33 + n;
            u32x4 o; o.x = pk2(s[0 * 33], s[1 * 33]); o.y = pk2(s[2 * 33], s[3 * 33]); o.z = pk2(s[4 * 33], s[5 * 33]); o.w = pk2(s[6 * 33], s[7 * 33]);
            if (NTST) __builtin_nontemporal_store(o, (u32x4*)(WT + (size_t)(drow0 + n) * K + k0 + 8 * c)); else *(u32x4*)(WT + (size_t)(drow0 + n) * K + k0 + 8 * c) = o; }
    }
    LDS_WAIT();
}
constexpr int I_IN1 = 64 * 256, I_IN2 = 64 * 1, I_IN3 = 64 * 544, I_UP = 64 * 688, I_O = 64 * 128;
__device__ __forceinline__ void phase_quant_weights(Frame& F) {
    const int lane = F.lane, gw = F.vcu * NWAVES + F.wave, NGW = F.G * NWAVES;
    LAS float* scr = (LAS float*)(F.lds + F.wave * 8448);
    constexpr int NQ = (I8_PROJ ? I_IN1 + I_IN2 + I_IN3 : 0) + (I8_O ? I_O : 0) + (I8_UP ? I_UP : 0);
    if (NQ == 0) return;
    const float* Fw_in = karg<I_WIN>(); const float* Fw_up = karg<I_WUP>();
    unsigned* cm_in = (unsigned*)(F.ws + WS_CM_IN); unsigned* cm_up = (unsigned*)(F.ws + WS_CM_UP);
    for (int it = gw; it < NQ; it += NGW) {
        int r = it;
        if (I8_PROJ) {
            if (r < I_IN1) { transpose_item<2, false>(Fw_in, N_IN, 0, 256, F.ws + WS_BT_IN, D, 0, scr, r, lane, cm_in, WSP(float, WS_SB_IN)); continue; } r -= I_IN1;
            if (r < I_IN2) { transpose_item<2, false>(Fw_in, N_IN, 8192, 1, F.ws + WS_BT_IN, D, 25600, scr, r, lane, cm_in, WSP(float, WS_SB_IN)); continue; } r -= I_IN2;
            if (r < I_IN3) { transpose_item<2, false>(Fw_in, N_IN, 8224, 544, F.ws + WS_BT_IN, D, 8192, scr, r, lane, cm_in, WSP(float, WS_SB_IN)); continue; } r -= I_IN3;
        }
        if (I8_O) { if (r < I_O) { transpose_item<2, false>(karg<I_WO>(), D, 0, 128, F.ws + WS_BT_O, D, 0, scr, r, lane, (unsigned*)(F.ws + WS_CM_O), WSP(float, WS_SB_O)); continue; } r -= I_O; }
        if (I8_UP) transpose_item<2, true>(Fw_up, 2 * DFF, 0, 688, F.ws + WS_BT_UP, D, 0, scr, r, lane, cm_up, WSP(float, WS_SB_UP));
    }
    if (I8_PROJ) {
        u32x4* z = (u32x4*)(F.ws + WS_BT_IN + (size_t)N_IN * D); const int nz = (N_IN_PAD - N_IN) * D / 16;
        for (int i = F.vcu * NTHR + F.tid; i < nz; i += F.G * NTHR) z[i] = (u32x4){0u, 0u, 0u, 0u};
        for (int i = F.vcu * NTHR + F.tid; i < N_IN_PAD - N_IN; i += F.G * NTHR) WSP(float, WS_SB_IN)[N_IN + i] = 0.f;
    }
}
__device__ __forceinline__ void phase0(Frame& F) {
    const int tid = F.tid, lane = F.lane, wave = F.wave;
    { const float* b_gate = karg<I_BGATE>(); const float* a_log = karg<I_ALOG>(); const float* dt_bias = karg<I_DTBIAS>(); float* sm = WSP(float, WS_SMALL);
      if (blockIdx.x == 0) { for (int i = tid; i < 8192; i += NTHR) sm[i] = b_gate[i]; if (tid < 16) { sm[8192 + tid] = a_log[tid]; sm[8192 + 16 + tid] = dt_bias[tid]; } } }
    {
        const float* Fc = karg<I_C>(); const float* Fw_ada = karg<I_WADA>(); const float* Fb_ada = karg<I_BADA>();
        LAS f32x4* sc = (LAS f32x4*)F.lds;
        LAS float* red = (LAS float*)(F.lds + 65536);
        for (int k = tid; k < D; k += NTHR) { f32x4 v; v.x = silu_(Fc[k]); v.y = silu_(Fc[D + k]); v.z = silu_(Fc[2 * D + k]); v.w = silu_(Fc[3 * D + k]); sc[k] = v; }
        __syncthreads();
        float* mod = WSP(float, WS_MOD);
        const int cg = lane & 7, slot = tid >> 3;
        for (int unit = F.vcu; unit < NMOD / 32; unit += F.G) {
            const int n0 = unit * 32;
            float acc[4][4];
#pragma unroll
            for (int b = 0; b < 4; ++b)
#pragma unroll
                for (int j = 0; j < 4; ++j) acc[b][j] = 0.f;
            const float* wp = Fw_ada + (size_t)slot * NMOD + n0 + 4 * cg;
#pragma unroll 8
            for (int it = 0; it < 64; ++it) { const f32x4 w = __builtin_nontemporal_load((const f32x4*)(wp + (size_t)it * 64 * NMOD)); const f32x4 s = sc[slot + 64 * it];
#pragma unroll
                for (int b = 0; b < 4; ++b)
#pragma unroll
                    for (int j = 0; j < 4; ++j) acc[b][j] += s[b] * w[j]; }
#pragma unroll
            for (int b = 0; b < 4; ++b)
#pragma unroll
                for (int j = 0; j < 4; ++j) { float v = acc[b][j]; v += __shfl_xor(v, 8); v += __shfl_xor(v, 16); v += __shfl_xor(v, 32); acc[b][j] = v; }
            if (lane < 8) {
#pragma unroll
                for (int b = 0; b < 4; ++b)
#pragma unroll
                    for (int j = 0; j < 4; ++j) red[(wave * 8 + lane) * 16 + b * 4 + j] = acc[b][j]; }
            __syncthreads();
            if (tid < 128) { const int cg2 = tid >> 4, idx = tid & 15; float s = 0.f;
#pragma unroll
                for (int w = 0; w < 8; ++w) s += red[(w * 8 + cg2) * 16 + idx];
                const int b = idx >> 2, j = idx & 3, n = n0 + 4 * cg2 + j;
                mod[(size_t)b * NMOD + n] = s + Fb_ada[n]; }
            __syncthreads();
        }
    }
    if (!I8_PROJ) { u32x4* z = (u32x4*)(WSP(bf16, WS_BT_IN) + (size_t)N_IN * D); const int nz = (N_IN_PAD - N_IN) * D / 8;
      for (int i = F.vcu * NTHR + tid; i < nz; i += F.G * NTHR) z[i] = (u32x4){0u, 0u, 0u, 0u}; }
    LAS float* scr = (LAS float*)(F.lds + wave * 8448);
    const int gw = F.vcu * NWAVES + wave, NGW = F.G * NWAVES;
    constexpr int I_A = 32 * 128, I_B = 16 * 128, I_DN = 172 * 128;
    constexpr int NITEMS = I_IN1 + I_IN2 + I_IN3 + I_A + I_B + I_O + I_UP + I_DN;
    bf16* bt_in = WSP(bf16, WS_BT_IN); unsigned* cm_in = (unsigned*)(F.ws + WS_CM_IN); unsigned* cm_up = (unsigned*)(F.ws + WS_CM_UP);
    const float* Fw_in = karg<I_WIN>(); const float* Fw_a = karg<I_WA>(); const float* Fw_b = karg<I_WB>(); const float* Fw_o = karg<I_WO>(); const float* Fw_up = karg<I_WUP>(); const float* Fw_down = karg<I_WDOWN>();
    constexpr int OI = I8_PROJ ? 1 : 0, OU = I8_UP ? 1 : 0, OO = I8_O ? 1 : 0;
    for (int it = gw; it < NITEMS; it += NGW) {
        int r = it;
        if (r < I_IN1) { transpose_item<OI, false>(Fw_in, N_IN, 0, 256, bt_in, D, 0, scr, r, lane, cm_in); continue; } r -= I_IN1;
        if (r < I_IN2) { transpose_item<OI, false>(Fw_in, N_IN, 8192, 1, bt_in, D, 25600, scr, r, lane, cm_in); continue; } r -= I_IN2;
        if (r < I_IN3) { transpose_item<OI, false>(Fw_in, N_IN, 8224, 544, bt_in, D, 8192, scr, r, lane, cm_in); continue; } r -= I_IN3;
#if CATAB
        if (r < I_A) { transpose_item<0, false>(Fw_a, D, 0, 128, WSP(bf16, WS_BT_A), 3072, 0, scr, r, lane); continue; } r -= I_A;
        if (r < I_B) { transpose_item<0, false>(Fw_b, D, 0, 128, WSP(bf16, WS_BT_A) + 2048, 3072, 0, scr, r, lane); continue; } r -= I_B;
#else
        if (r < I_A) { transpose_item<0, false>(Fw_a, D, 0, 128, WSP(bf16, WS_BT_A), 2048, 0, scr, r, lane); continue; } r -= I_A;
        if (r < I_B) { transpose_item<0, false>(Fw_b, D, 0, 128, WSP(bf16, WS_BT_B), 1024, 0, scr, r, lane); continue; } r -= I_B;
#endif
        if (r < I_O) { transpose_item<OO, false>(Fw_o, D, 0, 128, WSP(bf16, WS_BT_O), D, 0, scr, r, lane, (unsigned*)(F.ws + WS_CM_O)); continue; } r -= I_O;
        if (r < I_UP) { transpose_item<OU, true, true>(Fw_up, 2 * DFF, 0, 688, WSP(bf16, WS_BT_UP), D, 0, scr, r, lane, cm_up); continue; } r -= I_UP;
        transpose_item<0, false, true>(Fw_down, D, 0, 128, WSP(bf16, WS_BT_DN), DFF, 0, scr, r, lane);
    }
}

__device__ __forceinline__ void phase_quant_rows(Frame& F) {
    const int gw = F.vcu * NWAVES + F.wave, NGW = F.G * NWAVES, lane = F.lane;
    const bf16* TMb = WSP(bf16, WS_TM); unsigned char* Q = F.ws + WS_TMQ; const unsigned* rm = (const unsigned*)(F.ws + WS_RM_O); float* sA = WSP(float, WS_SA_O);
    for (int m = gw; m < M; m += NGW) {
        const float am = __uint_as_float(rm[m]), inv = am > 0.f ? 127.0f / am : 0.f;
        const u32x4* src = (const u32x4*)(TMb + (size_t)m * D) + lane; u32x2* dst = (u32x2*)(Q + (size_t)m * D) + lane;
#pragma unroll
        for (int j = 0; j < 8; ++j) { float f[8]; unpack8(__builtin_nontemporal_load(src + 64 * j), f);
#pragma unroll
            for (int e = 0; e < 8; ++e) f[e] = fminf(fmaxf(f[e] * inv, -127.f), 127.f);
            u32x2 w; w.x = q8x4(f[0], f[1], f[2], f[3], 1.0f); w.y = q8x4(f[4], f[5], f[6], f[7], 1.0f); dst[64 * j] = w; }
        if (lane == 0) sA[m] = am * (1.0f / 127.0f);
    }
}


__device__ __forceinline__ void phase_bg_mini(Frame& F) {
    typedef int i32x4 __attribute__((ext_vector_type(4)));
    const int lane = F.lane, wave = F.wave, g4 = lane >> 4, c16 = lane & 15;
    const unsigned char* Aq = F.ws + WS_H; const unsigned char* Bq = F.ws + WS_BT_IN + (size_t)25600 * D;
    const float* sA = WSP(float, WS_SA_IN); const float* sB = WSP(float, WS_SB_IN) + 25600; const float* small = WSP(float, WS_SMALL); float* bg = WSP(float, WS_BG);
    LAS i32x4* red = (LAS i32x4*)F.lds;
    for (int rb = F.vcu; rb < M / 64; rb += F.G) {
        const int m0 = rb * 64;
        i32x4 acc[4][2];
#pragma unroll
        for (int mt = 0; mt < 4; ++mt) { acc[mt][0] = (i32x4){0, 0, 0, 0}; acc[mt][1] = (i32x4){0, 0, 0, 0}; }
#pragma unroll 2
        for (int ks = 0; ks < 8; ++ks) { const int kb = (8 * wave + ks) * 64 + 16 * g4;
            i32x4 af[4], bf[2];
#pragma unroll
            for (int mt = 0; mt < 4; ++mt) af[mt] = *(const i32x4*)(Aq + (size_t)(m0 + 16 * mt + c16) * D + kb);
#pragma unroll
            for (int nt = 0; nt < 2; ++nt) bf[nt] = *(const i32x4*)(Bq + (size_t)(16 * nt + c16) * D + kb);
#pragma unroll
            for (int mt = 0; mt < 4; ++mt)
#pragma unroll
                for (int nt = 0; nt < 2; ++nt) acc[mt][nt] = __builtin_amdgcn_mfma_i32_16x16x64_i8(af[mt], bf[nt], acc[mt][nt], 0, 0, 0);
        }
        __syncthreads();
#pragma unroll
        for (int mt = 0; mt < 4; ++mt)
#pragma unroll
            for (int nt = 0; nt < 2; ++nt) red[(wave * 8 + mt * 2 + nt) * 64 + lane] = acc[mt][nt];
        __syncthreads();
        { const int mt = wave >> 1, nt = wave & 1;
          i32x4 s = (i32x4){0, 0, 0, 0};
#pragma unroll
          for (int w2 = 0; w2 < 8; ++w2) s = s + red[(w2 * 8 + wave) * 64 + lane];
          const int col = 16 * nt + c16, hh = col & 15; const float sb = sB[col];
          const float ea = -fexp(small[8192 + hh]), db = small[8192 + 16 + hh];
#pragma unroll
          for (int r = 0; r < 4; ++r) { const int row = m0 + 16 * mt + 4 * g4 + r; const float v = (float)s[r] * sA[row] * sb;
              const float o = (col < 16) ? __builtin_amdgcn_rcpf(1.0f + fexp(-v)) : ea * (fmaxf(v + db, 0.f) + log1pf(fexp(-fabsf(v + db))));
              bg[(size_t)row * 32 + col] = o; } }
    }
    __syncthreads();
}

__device__ __forceinline__ void phase_norm_mod_b16(Frame& F, const bf16* XB, int shift_chunk, int scale_chunk, bf16* H) {
    const int gw = F.vcu * NWAVES + F.wave, NGW = F.G * NWAVES, lane = F.lane;
    const float* mod = WSP(float, WS_MOD);
    const int rpw = (M + NGW - 1) / NGW, m0 = gw * rpw, m1 = (m0 + rpw < M) ? m0 + rpw : M;
    u32x4 v[8], nv[8]; f32x4 sc[16], sh[16]; int bcur = -1;
    if (m0 < m1) { const u32x4* xr = (const u32x4*)(XB + (size_t)m0 * D) + lane;
#pragma unroll
        for (int j = 0; j < 8; ++j) v[j] = __builtin_nontemporal_load(xr + 64 * j); }
    for (int m = m0; m < m1; ++m) {
        const int b = m >> 12;
        if (m + 1 < m1) { const u32x4* xn = (const u32x4*)(XB + (size_t)(m + 1) * D) + lane;
#pragma unroll
            for (int j = 0; j < 8; ++j) nv[j] = __builtin_nontemporal_load(xn + 64 * j); }
        if (b != bcur) { bcur = b;
            const f32x4* scp = (const f32x4*)(mod + (size_t)b * NMOD + scale_chunk * D) + 2 * lane;
            const f32x4* shp = (const f32x4*)(mod + (size_t)b * NMOD + shift_chunk * D) + 2 * lane;
#pragma unroll
            for (int j = 0; j < 8; ++j) { sc[2 * j] = scp[128 * j] + 1.0f; sc[2 * j + 1] = scp[128 * j + 1] + 1.0f; sh[2 * j] = shp[128 * j]; sh[2 * j + 1] = shp[128 * j + 1]; } }
        float ss = 0.f;
#pragma unroll
        for (int j = 0; j < 8; ++j) { float f[8]; unpack8(v[j], f);
#pragma unroll
            for (int e = 0; e < 8; ++e) ss += f[e] * f[e]; }
        const float rstd = rsqrtf(wave_sum(ss) * (1.f / D) + EPS);
        u32x4* o8 = (u32x4*)(H + (size_t)m * D) + lane;
#pragma unroll
        for (int j = 0; j < 8; ++j) { float f[8]; unpack8(v[j], f);
#pragma unroll
            for (int e = 0; e < 4; ++e) { f[e] = f[e] * rstd * sc[2 * j][e] + sh[2 * j][e]; f[4 + e] = f[4 + e] * rstd * sc[2 * j + 1][e] + sh[2 * j + 1][e]; }
            o8[64 * j] = pack8(f); }
#pragma unroll
        for (int j = 0; j < 8; ++j) v[j] = nv[j];
    }
}
template <bool ROPE, bool Q8> __device__ __forceinline__ void phase_norm_mod(Frame& F, const float* X, int shift_chunk, int scale_chunk, bf16* H, float* sA) {
    const int gw = F.vcu * NWAVES + F.wave, NGW = F.G * NWAVES, lane = F.lane;
    const float* mod = WSP(float, WS_MOD);
    const int* positions = ROPE ? (const int*)karg<I_POS>() : nullptr;
    const float invf = ROPE ? powf(500000.0f, -(float)(lane & 15) * (1.0f / 16.0f)) : 0.f;
    f32x4 v[16], nv[16];
    if (gw < M) { const f32x4* xr = (const f32x4*)(X + (size_t)gw * D) + lane;
#pragma unroll
        for (int j = 0; j < 16; ++j) v[j] = __builtin_nontemporal_load(xr + 64 * j); }
    for (int m = gw; m < M; m += NGW) {
        const int b = m >> 12;
        int posn = 0; if (ROPE) posn = positions[m];
        if (m + NGW < M) { const f32x4* xn = (const f32x4*)(X + (size_t)(m + NGW) * D) + lane;
#pragma unroll
            for (int j = 0; j < 16; ++j) nv[j] = __builtin_nontemporal_load(xn + 64 * j); }
        if (ROPE) { float sn, cs; sincosf((float)posn * invf, &sn, &cs); if (lane < 32) WSP(float, WS_ROPE)[(size_t)m * 32 + lane] = (lane < 16) ? cs : sn; }
        float ss = 0.f;
#pragma unroll
        for (int j = 0; j < 16; ++j) ss += (v[j].x * v[j].x + v[j].y * v[j].y) + (v[j].z * v[j].z + v[j].w * v[j].w);
        const float rstd = rsqrtf(wave_sum(ss) * (1.f / D) + EPS);
        const f32x4* scp = (const f32x4*)(mod + (size_t)b * NMOD + scale_chunk * D) + lane;
        const f32x4* shp = (const f32x4*)(mod + (size_t)b * NMOD + shift_chunk * D) + lane;
        if (Q8) {
            float am = 0.f;
#pragma unroll
            for (int j = 0; j < 16; ++j) { const f32x4 sc = scp[64 * j], sh = shp[64 * j]; v[j] = v[j] * rstd * (sc + 1.0f) + sh;
                am = fmaxf(am, fmaxf(fmaxf(fabsf(v[j].x), fabsf(v[j].y)), fmaxf(fabsf(v[j].z), fabsf(v[j].w)))); }
#pragma unroll
            for (int o = 1; o < 64; o <<= 1) am = fmaxf(am, __shfl_xor(am, o));
            const float inv = am > 0.f ? 127.0f / am : 0.f;
            unsigned* o4 = (unsigned*)((unsigned char*)H + (size_t)m * D) + lane;
#pragma unroll
            for (int j = 0; j < 16; ++j) o4[64 * j] = q8x4(v[j].x, v[j].y, v[j].z, v[j].w, inv);
            if (lane == 0) sA[m] = am * (1.0f / 127.0f);
        } else {
        u32x2* o8 = (u32x2*)(H + (size_t)m * D) + lane;
#pragma unroll
        for (int j = 0; j < 16; ++j) { const f32x4 sc = scp[64 * j], sh = shp[64 * j]; const f32x4 o = v[j] * rstd * (sc + 1.0f) + sh;
            u32x2 w; w.x = pk2(o.x, o.y); w.y = pk2(o.z, o.w); o8[64 * j] = w; }
        }
#pragma unroll
        for (int j = 0; j < 16; ++j) v[j] = nv[j];
    }
}


__device__ __forceinline__ bf16x8 ldfrag_sw(const LAS unsigned char* base, int row0, int k0, int lane) {
    const int chunk = (k0 >> 3) + (lane >> 4), sw = (row0 >> 4) & 7;
    return *(const LAS bf16x8*)(base + (row0 + (lane & 15)) * 144 + ((chunk ^ sw) << 4));
}
template <int J> __device__ __forceinline__ void d1_solve_steps(float (&Tr)[16], const float (&Ar)[16]) {
    if constexpr (J < 15) {
#pragma unroll
        for (int c = 0; c <= J; ++c) {
            const float tj = __builtin_bit_cast(float, __builtin_amdgcn_update_dpp(0, __builtin_bit_cast(int, Tr[c]), 0x150 + J, 0xf, 0xf, false));
            Tr[c] -= Ar[J] * tj; }
        d1_solve_steps<J + 1>(Tr, Ar);
    }
}
constexpr int D1_QN = 0, D1_KN = 17408, D1_VBT = 34816, D1_KBDT = 53248, D1_KDT = 71680, D1_AM = 90112, D1_TM = 107520, D1_SC = 116736, D1_TT = 117504, D1_CW = 134912;
__device__ __forceinline__ void d1_load_cw(Frame& F, int h) {
    const float* conv_qkv = karg<I_CONVQKV>(); LAS float* cwl = (LAS float*)(F.lds + D1_CW);
    for (int i = F.tid; i < 1536; i += NTHR) { const int j = i / 384, rem = i - j * 384, which = rem >> 7, d = rem & 127; cwl[i] = conv_qkv[j * 6144 + which * 2048 + h * 128 + d]; }
    __syncthreads();
}
__device__ __forceinline__ void d1_item(Frame& F, int ci, int& cached_h) {
    const int tid = F.tid, lane = F.lane, wave = F.wave, g4 = lane >> 4, c16 = lane & 15;
    const int h = ci & 15, n = (ci >> 4) & 63, b = ci >> 10;
    const int m0 = b * T + n * 64;
    if (h != cached_h) { d1_load_cw(F, h); cached_h = h; }
    LAS unsigned char* L = F.lds;
    LAS float* sc_beta = (LAS float*)(L + D1_SC); LAS float* sc_gc = sc_beta + 64;
    LAS float* AM = (LAS float*)(L + D1_AM);
    unsigned char* outp = F.ws + WS_D1 + (size_t)((b * 16 + h) * 64 + n) * D1_CHUNK_BYTES;
    bf16* Wg = (bf16*)outp; bf16* QDg = (bf16*)(outp + 16384); bf16* KDTg = (bf16*)(outp + 32768); u32x2* UFg = (u32x2*)(outp + 49152); bf16* AQKg = (bf16*)(outp + 65536);
    const float* bg = WSP(float, WS_BG);
    u32x4 raw[3][4][2];
#define D1_LOAD_RAW(which) do { const int tok_ = tid >> 3, sub_ = tid & 7, t_ = n * 64 + tok_; const bf16* qkva_ = WSP(bf16, WS_QKVA); \
        _Pragma("unroll") for (int j = 0; j < 4; ++j) { raw[which][j][0] = (u32x4){0u, 0u, 0u, 0u}; raw[which][j][1] = (u32x4){0u, 0u, 0u, 0u}; \
            if (t_ - 3 + j >= 0) { const bf16* rp = qkva_ + (size_t)(m0 + tok_ - 3 + j) * 6144 + (which) * 2048 + h * 128 + 16 * sub_; raw[which][j][0] = *(const u32x4*)rp; raw[which][j][1] = *(const u32x4*)(rp + 8); } } } while (0)
    D1_LOAD_RAW(0); D1_LOAD_RAW(1);
    if (wave == 0) {
        const float be = bg[(size_t)(m0 + lane) * 32 + h]; float gc = bg[(size_t)(m0 + lane) * 32 + 16 + h];
#pragma unroll
        for (int o = 1; o < 64; o <<= 1) { const float t = __shfl_up(gc, o); if (lane >= o) gc += t; }
        sc_beta[lane] = be; sc_gc[lane] = gc;
    }
    __syncthreads();
    const float glast = sc_gc[63];
    {
        const int tok = tid >> 3, sub = tid & 7, t = n * 64 + tok;
        const float be = sc_beta[tok], gc = sc_gc[tok];
        const float eg = fexp(gc), ekd = fexp(glast - gc);
        const int tsw = (((tok >> 3) ^ sub) << 4) + (tok & 7) * 2;
#pragma unroll
        for (int which = 0; which < 3; ++which) {
            const int ch0 = which * 2048 + h * 128 + 16 * sub;
            float a[16];
#pragma unroll
            for (int e = 0; e < 16; ++e) a[e] = 0.f;
#pragma unroll
            for (int j = 0; j < 4; ++j) {
                float x[16]; { float t0[8], t1[8]; unpack8(raw[which][j][0], t0); unpack8(raw[which][j][1], t1);
#pragma unroll
                    for (int e = 0; e < 8; ++e) { x[e] = t0[e]; x[8 + e] = t1[e]; } }
                const LAS f32x4* cw = (const LAS f32x4*)(L + D1_CW + ((j * 3 + which) * 128 + 16 * sub) * 4);
#pragma unroll
                for (int q = 0; q < 4; ++q) { const f32x4 w = cw[q];
#pragma unroll
                    for (int e = 0; e < 4; ++e) a[4 * q + e] += w[e] * x[4 * q + e]; }
            }
            float ss = 0.f;
#pragma unroll
            for (int e = 0; e < 16; ++e) { a[e] = silu_(a[e]); ss += a[e] * a[e]; }
            if (which < 2) {
                ss += __shfl_xor(ss, 1); ss += __shfl_xor(ss, 2); ss += __shfl_xor(ss, 4);
                const float rs = rsqrtf(ss + EPS) * (which == 0 ? 0.08838834764831845f : 1.0f);
#pragma unroll
                for (int e = 0; e < 16; ++e) a[e] *= rs;
            }
            if (which == 0) {
                asm volatile("" ::: "memory"); D1_LOAD_RAW(2);
                float lo[8], hi[8];
#pragma unroll
                for (int e = 0; e < 8; ++e) { lo[e] = a[e]; hi[e] = a[8 + e]; }
                *(LAS u32x4*)(L + D1_QN + tok * 272 + sub * 32) = pack8(lo); *(LAS u32x4*)(L + D1_QN + tok * 272 + sub * 32 + 16) = pack8(hi);
#pragma unroll
                for (int e = 0; e < 8; ++e) { lo[e] *= eg; hi[e] *= eg; }
                *(u32x4*)(QDg + tok * 128 + 16 * sub) = pack8(lo); *(u32x4*)(QDg + tok * 128 + 16 * sub + 8) = pack8(hi);
            } else if (which == 1) {
                float lo[8], hi[8];
#pragma unroll
                for (int e = 0; e < 8; ++e) { lo[e] = a[e]; hi[e] = a[8 + e]; }
                *(LAS u32x4*)(L + D1_KN + tok * 272 + sub * 32) = pack8(lo); *(LAS u32x4*)(L + D1_KN + tok * 272 + sub * 32 + 16) = pack8(hi);
                const float f1 = be * eg;
#pragma unroll
                for (int e = 0; e < 16; ++e) {
                    *(LAS bf16*)(L + D1_KBDT + (16 * sub + e) * 144 + tsw) = (bf16)f2bf(a[e] * f1);
                    *(LAS bf16*)(L + D1_KDT + (16 * sub + e) * 144 + tsw) = (bf16)f2bf(a[e] * ekd); }
            } else {
#pragma unroll
                for (int e = 0; e < 16; ++e) *(LAS bf16*)(L + D1_VBT + (16 * sub + e) * 144 + tsw) = (bf16)f2bf(a[e] * be);
            }
        }
    }
    __syncthreads();
#pragma unroll
    for (int tt = 0; tt < 2; ++tt) {
        const int tix = wave + 8 * tt, ti = tix >> 2, tj = tix & 3;
        if (tj <= ti) {
            f32x4 acc = (f32x4){0.f, 0.f, 0.f, 0.f}, acc2 = (f32x4){0.f, 0.f, 0.f, 0.f};
#pragma unroll
            for (int s = 0; s < 4; ++s) {
                const bf16x8 ki = ldfrag(L + D1_KN, 272, 16 * ti, 32 * s, lane), kj = ldfrag(L + D1_KN, 272, 16 * tj, 32 * s, lane), qi = ldfrag(L + D1_QN, 272, 16 * ti, 32 * s, lane);
                acc = MFMA16(ki, kj, acc);
                acc2 = MFMA16(kj, qi, acc2);
            }
            { const int j = 16 * tj + c16; const float gcj = sc_gc[j];
#pragma unroll
              for (int r = 0; r < 4; ++r) { const int i = 16 * ti + 4 * g4 + r; const bool ok = i > j;
                  const float v = ok ? sc_beta[i] * fexp(sc_gc[i] - gcj) * acc[r] : 0.f; AM[i * 68 + j] = v; } }
            { const int i = 16 * ti + c16; const float gci = sc_gc[i]; float v[4];
#pragma unroll
              for (int r = 0; r < 4; ++r) { const int j = 16 * tj + 4 * g4 + r; const bool ok = i >= j; v[r] = ok ? fexp(gci - sc_gc[j]) * acc2[r] : 0.f; }
              u32x2 w; w.x = pk2(v[0], v[1]); w.y = pk2(v[2], v[3]); *(u32x2*)(AQKg + i * 64 + 16 * tj + 4 * g4) = w; }
        } else {
            *(u32x2*)(AQKg + (16 * ti + c16) * 64 + 16 * tj + 4 * g4) = (u32x2){0u, 0u};
        }
    }
#pragma unroll
    for (int i = 0; i < 2; ++i) { const int q = tid + NTHR * i, row = q >> 3, cc = q & 7;
        *(u32x4*)(KDTg + row * 64 + 8 * cc) = *(const LAS u32x4*)(L + D1_KDT + row * 144 + 16 * (cc ^ ((row >> 4) & 7))); }
    if (tid == 0) WSP(float, WS_DEC)[(b * 16 + h) * 64 + n] = fexp(glast);
    __syncthreads();
    LAS float* TT = (LAS float*)(L + D1_TT);
    if (wave == 0) {
        const int blk = g4, i = c16;
        float Ar[16], Tr[16];
#pragma unroll
        for (int q = 0; q < 4; ++q) { const f32x4 v = *(const LAS f32x4*)(AM + (16 * blk + i) * 68 + 16 * blk + 4 * q); Ar[4 * q] = v[0]; Ar[4 * q + 1] = v[1]; Ar[4 * q + 2] = v[2]; Ar[4 * q + 3] = v[3]; }
#pragma unroll
        for (int c = 0; c < 16; ++c) Tr[c] = (c == i) ? 1.f : 0.f;
        d1_solve_steps<0>(Tr, Ar);
#pragma unroll
        for (int q = 0; q < 4; ++q) *(LAS f32x4*)(TT + (16 * blk + i) * 68 + 16 * blk + 4 * q) = (f32x4){Tr[4 * q], Tr[4 * q + 1], Tr[4 * q + 2], Tr[4 * q + 3]};
    }
    __syncthreads();
#pragma unroll
    for (int d = 1; d < 4; ++d) {
        if (wave < 4 - d) {
            const int bi = wave + d, bj = wave;
            f32x4 S = (f32x4){0.f, 0.f, 0.f, 0.f};
#pragma unroll
            for (int kk = 0; kk < d; ++kk) { const int k = bj + kk;
#pragma unroll
                for (int s4 = 0; s4 < 4; ++s4) S = __builtin_amdgcn_mfma_f32_16x16x4f32(AM[(16 * bi + c16) * 68 + 16 * k + 4 * s4 + g4], TT[(16 * k + 4 * s4 + g4) * 68 + 16 * bj + c16], S, 0, 0, 0); }
            f32x4 R = (f32x4){0.f, 0.f, 0.f, 0.f};
#pragma unroll
            for (int s4 = 0; s4 < 4; ++s4) R = __builtin_amdgcn_mfma_f32_16x16x4f32(TT[(16 * bi + c16) * 68 + 16 * bi + 4 * g4 + s4], S[s4], R, 0, 0, 0);
#pragma unroll
            for (int r = 0; r < 4; ++r) TT[(16 * bi + 4 * g4 + r) * 68 + 16 * bj + c16] = -R[r];
        }
        __syncthreads();
    }
    { const int row = tid >> 3, col0 = (tid & 7) * 8; const bool up = (col0 >> 4) > (row >> 4);
      const f32x4 v0 = *(const LAS f32x4*)(TT + row * 68 + col0), v1 = *(const LAS f32x4*)(TT + row * 68 + col0 + 4);
      u32x4 w; w.x = pk2(v0[0], v0[1]); w.y = pk2(v0[2], v0[3]); w.z = pk2(v1[0], v1[1]); w.w = pk2(v1[2], v1[3]);
      if (up) w = (u32x4){0u, 0u, 0u, 0u};
      *(LAS u32x4*)(L + D1_TM + row * 144 + col0 * 2) = w; }
    __syncthreads();
#pragma unroll
    for (int ti = 0; ti < 4; ++ti) {
        f32x4 au = (f32x4){0.f, 0.f, 0.f, 0.f}, aw = (f32x4){0.f, 0.f, 0.f, 0.f};
#pragma unroll
        for (int s = 0; s < 2; ++s) {
            const bf16x8 tf = ldfrag(L + D1_TM, 144, 16 * ti, 32 * s, lane);
            au = MFMA16(tf, ldfrag_sw(L + D1_VBT, 16 * wave, 32 * s, lane), au);
            aw = MFMA16(ldfrag_sw(L + D1_KBDT, 16 * wave, 32 * s, lane), tf, aw);
        }
        u32x2 w; w.x = pk2(au[0], au[1]); w.y = pk2(au[2], au[3]); UFg[(ti * 8 + wave) * 64 + lane] = w;
        w.x = pk2(aw[0], aw[1]); w.y = pk2(aw[2], aw[3]); *(u32x2*)(Wg + (16 * ti + c16) * 128 + 16 * wave + 4 * g4) = w;
    }
    __syncthreads();
}

constexpr int D2_W = 0, D2_QD = 17408, D2_KDT = 34816, D2_AQK = 53248, D2_ST = 62464, D2_VNT = 97280;
__device__ __forceinline__ void d2_item(Frame& F, int bh) {
    const int tid = F.tid, lane = F.lane, wave = F.wave, g4 = lane >> 4, c16 = lane & 15;
    const int b = bh >> 4, h = bh & 15;
    LAS unsigned char* L = F.lds;
    const unsigned char* seq = F.ws + WS_D1 + (size_t)bh * 64 * D1_CHUNK_BYTES;
    const float* dec = WSP(float, WS_DEC) + bh * 64;
    bf16* OA = WSP(bf16, WS_OA);
    for (int i = tid; i < 34816 / 16; i += NTHR) *(LAS u32x4*)(L + D2_ST + 16 * i) = (u32x4){0u, 0u, 0u, 0u};
    if (wave >= 4) {
        const int lt = tid - 256;
        u32x4 pw[4], pq[4], pk[4], pa[2];
#define D2_LOAD(nn) do { const unsigned char* cp = seq + (size_t)(nn) * D1_CHUNK_BYTES; \
            _Pragma("unroll") for (int i = 0; i < 4; ++i) { const int q = lt + 256 * i; pw[i] = *(const u32x4*)(cp + 16 * q); pq[i] = *(const u32x4*)(cp + 16384 + 16 * q); pk[i] = *(const u32x4*)(cp + 32768 + 16 * q); } \
            _Pragma("unroll") for (int i = 0; i < 2; ++i) pa[i] = *(const u32x4*)(cp + 65536 + 16 * (lt + 256 * i)); } while (0)
        D2_LOAD(0);
        for (int n = 0; n < 64; ++n) {
            __syncthreads();
#pragma unroll
            for (int i = 0; i < 4; ++i) { const int q = lt + 256 * i;
                *(LAS u32x4*)(L + D2_W + (q >> 4) * 272 + (q & 15) * 16) = pw[i]; *(LAS u32x4*)(L + D2_QD + (q >> 4) * 272 + (q & 15) * 16) = pq[i];
                *(LAS u32x4*)(L + D2_KDT + (q >> 3) * 144 + (q & 7) * 16) = pk[i]; }
#pragma unroll
            for (int i = 0; i < 2; ++i) { const int q = lt + 256 * i; *(LAS u32x4*)(L + D2_AQK + (q >> 3) * 144 + (q & 7) * 16) = pa[i]; }
            __syncthreads();
            if (n + 1 < 64) D2_LOAD(n + 1);
        }
#undef D2_LOAD
    } else {
        f32x4 sacc[8][2];
#pragma unroll
        for (int k = 0; k < 8; ++k) { sacc[k][0] = (f32x4){0.f, 0.f, 0.f, 0.f}; sacc[k][1] = (f32x4){0.f, 0.f, 0.f, 0.f}; }
        u32x2 pu[4][2]; float pdec;
#define D2_LOADU(nn) do { const unsigned char* cp = seq + (size_t)(nn) * D1_CHUNK_BYTES; \
            _Pragma("unroll") for (int ti = 0; ti < 4; ++ti) _Pragma("unroll") for (int dt = 0; dt < 2; ++dt) pu[ti][dt] = *(const u32x2*)(cp + 49152 + ((ti * 8 + 2 * wave + dt) * 64 + lane) * 8); \
            pdec = dec[nn]; } while (0)
        D2_LOADU(0);
        for (int n = 0; n < 64; ++n) {
            __syncthreads();
            const float decay = pdec;
            __syncthreads();
        bf16x8 bS[4][2];
#pragma unroll
        for (int s = 0; s < 4; ++s)
#pragma unroll
            for (int dt = 0; dt < 2; ++dt) bS[s][dt] = ldfrag(L + D2_ST, 272, 16 * (2 * wave + dt), 32 * s, lane);
#pragma unroll
        for (int ti = 0; ti < 4; ++ti) {
            f32x4 va[2] = {(f32x4){0.f, 0.f, 0.f, 0.f}, (f32x4){0.f, 0.f, 0.f, 0.f}};
#pragma unroll
            for (int s = 0; s < 4; ++s) { const bf16x8 wf = ldfrag(L + D2_W, 272, 16 * ti, 32 * s, lane);
                va[0] = MFMA16(wf, bS[s][0], va[0]); va[1] = MFMA16(wf, bS[s][1], va[1]); }
#pragma unroll
            for (int dt = 0; dt < 2; ++dt) {
                const float v0 = bflo(pu[ti][dt].x) - va[dt][0], v1 = bfhi(pu[ti][dt].x) - va[dt][1], v2 = bflo(pu[ti][dt].y) - va[dt][2], v3 = bfhi(pu[ti][dt].y) - va[dt][3];
                u32x2 w; w.x = pk2(v0, v1); w.y = pk2(v2, v3);
                *(LAS u32x2*)(L + D2_VNT + (16 * (2 * wave + dt) + c16) * 144 + (16 * ti + 4 * g4) * 2) = w; }
        }
        if (n + 1 < 64) D2_LOADU(n + 1);
        bf16x8 bV[2][2];
#pragma unroll
        for (int s2 = 0; s2 < 2; ++s2)
#pragma unroll
            for (int dt = 0; dt < 2; ++dt) bV[s2][dt] = ldfrag(L + D2_VNT, 144, 16 * (2 * wave + dt), 32 * s2, lane);
#pragma unroll
        for (int ti = 0; ti < 4; ++ti) {
            f32x4 oa[2] = {(f32x4){0.f, 0.f, 0.f, 0.f}, (f32x4){0.f, 0.f, 0.f, 0.f}};
#pragma unroll
            for (int s = 0; s < 4; ++s) { const bf16x8 qf = ldfrag(L + D2_QD, 272, 16 * ti, 32 * s, lane);
                oa[0] = MFMA16(bS[s][0], qf, oa[0]); oa[1] = MFMA16(bS[s][1], qf, oa[1]); }
#pragma unroll
            for (int s2 = 0; s2 < 2; ++s2) { const bf16x8 af = ldfrag(L + D2_AQK, 144, 16 * ti, 32 * s2, lane);
                oa[0] = MFMA16(bV[s2][0], af, oa[0]); oa[1] = MFMA16(bV[s2][1], af, oa[1]); }
#pragma unroll
            for (int dt = 0; dt < 2; ++dt) { u32x2 w; w.x = pk2(oa[dt][0], oa[dt][1]); w.y = pk2(oa[dt][2], oa[dt][3]);
                *(u32x2*)(OA + (size_t)(b * T + n * 64 + 16 * ti + c16) * 2048 + h * 128 + 16 * (2 * wave + dt) + 4 * g4) = w; }
        }
#pragma unroll
        for (int k = 0; k < 8; ++k) {
            const bf16x8 k0 = ldfrag(L + D2_KDT, 144, 16 * k, 0, lane), k1 = ldfrag(L + D2_KDT, 144, 16 * k, 32, lane);
#pragma unroll
            for (int dt = 0; dt < 2; ++dt) {
                f32x4 sa = sacc[k][dt] * decay;
                sa = MFMA16(k0, bV[0][dt], sa);
                sa = MFMA16(k1, bV[1][dt], sa);
                sacc[k][dt] = sa;
                u32x2 w; w.x = pk2(sa[0], sa[1]); w.y = pk2(sa[2], sa[3]);
                *(LAS u32x2*)(L + D2_ST + (16 * (2 * wave + dt) + c16) * 272 + (16 * k + 4 * g4) * 2) = w; }
        }
        }
#undef D2_LOADU
    }
    __syncthreads();
}

constexpr int SW_KT = 0, SW_VT = 69632;
#define TR_READ16(o, a0, a1) asm volatile( \
    "ds_read_b64_tr_b16 %0, %16\n\tds_read_b64_tr_b16 %1, %17\n\tds_read_b64_tr_b16 %2, %16 offset:32\n\tds_read_b64_tr_b16 %3, %17 offset:32\n\t" \
    "ds_read_b64_tr_b16 %4, %16 offset:64\n\tds_read_b64_tr_b16 %5, %17 offset:64\n\tds_read_b64_tr_b16 %6, %16 offset:96\n\tds_read_b64_tr_b16 %7, %17 offset:96\n\t" \
    "ds_read_b64_tr_b16 %8, %16 offset:128\n\tds_read_b64_tr_b16 %9, %17 offset:128\n\tds_read_b64_tr_b16 %10, %16 offset:160\n\tds_read_b64_tr_b16 %11, %17 offset:160\n\t" \
    "ds_read_b64_tr_b16 %12, %16 offset:192\n\tds_read_b64_tr_b16 %13, %17 offset:192\n\tds_read_b64_tr_b16 %14, %16 offset:224\n\tds_read_b64_tr_b16 %15, %17 offset:224\n\t" \
    "s_waitcnt lgkmcnt(0)" \
    : "=&v"(o[0]), "=&v"(o[1]), "=&v"(o[2]), "=&v"(o[3]), "=&v"(o[4]), "=&v"(o[5]), "=&v"(o[6]), "=&v"(o[7]), "=&v"(o[8]), "=&v"(o[9]), "=&v"(o[10]), "=&v"(o[11]), "=&v"(o[12]), "=&v"(o[13]), "=&v"(o[14]), "=&v"(o[15]) \
    : "v"(a0), "v"(a1) : "memory")
__device__ __forceinline__ void swa_unit(Frame& F, int u) {
    const int tid = F.tid, lane = F.lane, wave = F.wave, g4 = lane >> 4, c16 = lane & 15;
    const int b = u / 768, rem = u - b * 768, grp = rem >> 8, rem2 = rem & 255, h = rem2 >> 5, xx = rem2 & 31;
    const int dsh = 2 * grp, dil = 1 << dsh, nbsh = 5 - dsh;
    const int r = xx >> nbsh, ib = xx & ((1 << nbsh) - 1);
    LAS unsigned char* L = F.lds;
    const bf16* qkvb = WSP(bf16, WS_QKVB);
    const size_t colq = (size_t)grp * 3072 + h * 128, colk = colq + 1024, colv = colq + 2048;
    const float* k_gain = karg<I_KGAIN>(); const float* q_gain = karg<I_QGAIN>(); const float* rope = WSP(float, WS_ROPE);
    u32x4 kraw[2][4], vraw[8];
#pragma unroll
    for (int pass = 0; pass < 2; ++pass) { const int key = 128 * pass + (tid >> 2), qd = tid & 3, nk = 128 * (ib - 1) + key;
#pragma unroll
        for (int q = 0; q < 4; ++q) kraw[pass][q] = (u32x4){0u, 0u, 0u, 0u};
        if (nk >= 0) { const bf16* kp = qkvb + (size_t)(b * T + r + dil * nk) * 9216 + colk + 32 * qd;
#pragma unroll
            for (int q = 0; q < 4; ++q) kraw[pass][q] = *(const u32x4*)(kp + 8 * q); } }
#pragma unroll
    for (int i = 0; i < 8; ++i) { const int q = tid + NTHR * i, key = q >> 4, cc = q & 15; const int nk = 128 * (ib - 1) + key;
        vraw[i] = (u32x4){0u, 0u, 0u, 0u};
        if (nk >= 0) vraw[i] = *(const u32x4*)(qkvb + (size_t)(b * T + r + dil * nk) * 9216 + colv + 8 * cc); }
#pragma unroll
    for (int pass = 0; pass < 2; ++pass) {
        const int key = 128 * pass + (tid >> 2), qd = tid & 3;
        const int nk = 128 * (ib - 1) + key;
        u32x4 outw[4];
        if (nk >= 0) {
            const int mk = b * T + r + dil * nk;
            float v[32]; float ss = 0.f;
#pragma unroll
            for (int q = 0; q < 4; ++q) { float t8[8]; unpack8(kraw[pass][q], t8);
#pragma unroll
                for (int e = 0; e < 8; ++e) { v[8 * q + e] = t8[e]; ss += t8[e] * t8[e]; } }
            ss += __shfl_xor(ss, 1); ss += __shfl_xor(ss, 2);
            const float rstd = rsqrtf(ss * (1.f / 128.f) + EPS);
            const float* gp = k_gain + 32 * qd;
#pragma unroll
            for (int e = 0; e < 32; ++e) v[e] *= rstd * gp[e];
            if (qd == 0) {
                const f32x4* rt = (const f32x4*)(rope + (size_t)mk * 32);
#pragma unroll
                for (int q = 0; q < 4; ++q) { const f32x4 cs = rt[q], sn = rt[4 + q];
#pragma unroll
                    for (int e = 0; e < 4; ++e) { const int j = 4 * q + e; const float x1 = v[j], x2 = v[16 + j]; v[j] = x1 * cs[e] - x2 * sn[e]; v[16 + j] = x2 * cs[e] + x1 * sn[e]; } }
            }
#pragma unroll
            for (int q = 0; q < 4; ++q) { float t8[8];
#pragma unroll
                for (int e = 0; e < 8; ++e) t8[e] = v[8 * q + e];
                outw[q] = pack8(t8); }
        } else {
#pragma unroll
            for (int q = 0; q < 4; ++q) outw[q] = (u32x4){0u, 0u, 0u, 0u};
        }
#pragma unroll
        for (int q = 0; q < 4; ++q) *(LAS u32x4*)(L + SW_KT + key * 272 + qd * 64 + 16 * q) = outw[q];
    }
#pragma unroll
    for (int i = 0; i < 8; ++i) { const int q = tid + NTHR * i, key = q >> 4, cc = q & 15; *(LAS u32x4*)(L + SW_VT + key * 272 + 16 * cc) = vraw[i]; }
    const int qi = 16 * wave + c16;
    const int mq = b * T + r + dil * (128 * ib + qi);
    bf16x8 qf[4];
    {
        const bf16* qp = qkvb + (size_t)mq * 9216 + colq + 8 * g4;
        float v[4][8]; float ss = 0.f;
#pragma unroll
        for (int s = 0; s < 4; ++s) { unpack8(*(const u32x4*)(qp + 32 * s), v[s]);
#pragma unroll
            for (int e = 0; e < 8; ++e) ss += v[s][e] * v[s][e]; }
        ss += __shfl_xor(ss, 16); ss += __shfl_xor(ss, 32);
        const float rstd = rsqrtf(ss * (1.f / 128.f) + EPS);
#pragma unroll
        for (int s = 0; s < 4; ++s)
#pragma unroll
            for (int e = 0; e < 8; ++e) v[s][e] *= rstd * q_gain[32 * s + 8 * g4 + e];
        const f32x4* rt = (const f32x4*)(rope + (size_t)mq * 32 + 8 * (g4 & 1));
        const f32x4 c0 = rt[0], c1 = rt[1], s0 = rt[4], s1 = rt[5];
#pragma unroll
        for (int e = 0; e < 8; ++e) { const float cs = e < 4 ? c0[e & 3] : c1[e & 3], sn = e < 4 ? s0[e & 3] : s1[e & 3];
            const float xo = v[0][e], xp = __shfl_xor(xo, 32);
            v[0][e] = (g4 < 2) ? (xo * cs - xp * sn) : (xo * cs + xp * sn); }
#pragma unroll
        for (int s = 0; s < 4; ++s) { float t8[8];
#pragma unroll
            for (int e = 0; e < 8; ++e) t8[e] = v[s][e] * 0.08838834764831845f;
            const u32x4 w = pack8(t8); qf[s] = __builtin_bit_cast(bf16x8, w); }
    }
    __syncthreads();
    f32x4 sacc[9];
#pragma unroll
    for (int kk = 0; kk < 9; ++kk) { f32x4 a = (f32x4){0.f, 0.f, 0.f, 0.f};
#pragma unroll
        for (int s = 0; s < 4; ++s) a = MFMA16(ldfrag(L + SW_KT, 272, 16 * (wave + kk), 32 * s, lane), qf[s], a);
        sacc[kk] = a; }
    float mx = -INFINITY;
#pragma unroll
    for (int kk = 0; kk < 9; ++kk)
#pragma unroll
        for (int rr = 0; rr < 4; ++rr) { const int ki = 16 * (wave + kk) + 4 * g4 + rr; const bool ok = (ki >= qi) && (ki <= qi + 128) && (ib > 0 || ki >= 128);
            const float sv = ok ? sacc[kk][rr] : -INFINITY; sacc[kk][rr] = sv; mx = fmaxf(mx, sv); }
    mx = fmaxf(mx, __shfl_xor(mx, 16)); mx = fmaxf(mx, __shfl_xor(mx, 32));
    float den = 0.f;
#pragma unroll
    for (int kk = 0; kk < 9; ++kk)
#pragma unroll
        for (int rr = 0; rr < 4; ++rr) { const float p = fexp(sacc[kk][rr] - mx); sacc[kk][rr] = p; den += p; }
    den += __shfl_xor(den, 16); den += __shfl_xor(den, 32);
    const float rden = __builtin_amdgcn_rcpf(den);
    f32x4 oacc[8];
#pragma unroll
    for (int dt = 0; dt < 8; ++dt) oacc[dt] = (f32x4){0.f, 0.f, 0.f, 0.f};
    typedef short s16x4 __attribute__((ext_vector_type(4)));
    const LAS unsigned char* vlane = L + SW_VT + ((c16 >> 2) * 272) + (c16 & 3) * 8;
#pragma unroll
    for (int pp = 0; pp < 5; ++pp) {
        u32x4 pw; pw.x = pk2(sacc[2 * pp][0], sacc[2 * pp][1]); pw.y = pk2(sacc[2 * pp][2], sacc[2 * pp][3]);
        if (pp < 4) { pw.z = pk2(sacc[2 * pp + 1][0], sacc[2 * pp + 1][1]); pw.w = pk2(sacc[2 * pp + 1][2], sacc[2 * pp + 1][3]); } else { pw.z = 0u; pw.w = 0u; }
        const bf16x8 pf = __builtin_bit_cast(bf16x8, pw);
        const int t0 = wave + 2 * pp; const int t1 = (t0 + 1 > 15) ? 15 : (t0 + 1);
        const LAS unsigned char* a0 = vlane + (16 * t0 + 4 * g4) * 272; const LAS unsigned char* a1 = vlane + (16 * t1 + 4 * g4) * 272;
#pragma unroll
        for (int dt = 0; dt < 8; ++dt) {
            const s16x4 lo = __builtin_amdgcn_ds_read_tr16_b64_v4i16((LAS s16x4*)(a0 + 32 * dt)), hi = __builtin_amdgcn_ds_read_tr16_b64_v4i16((LAS s16x4*)(a1 + 32 * dt));
            oacc[dt] = MFMA16(__builtin_shufflevector(lo, hi, 0, 1, 2, 3, 4, 5, 6, 7), pf, oacc[dt]); }
    }
    bf16* so = WSP(bf16, WS_SWAO) + (size_t)grp * M * 1024 + (size_t)mq * 1024 + h * 128 + 4 * g4;
#pragma unroll
    for (int dt = 0; dt < 8; ++dt) { u32x2 w; w.x = pk2(oacc[dt][0] * rden, oacc[dt][1] * rden); w.y = pk2(oacc[dt][2] * rden, oacc[dt][3] * rden); *(u32x2*)(so + 16 * dt) = w; }
    if (g4 == 0) WSP(float, WS_LSE)[((size_t)grp * M + mq) * 8 + h] = mx + 0.6931471805599453f * __builtin_amdgcn_logf(den);
    __syncthreads();
}

struct MergeRow { u32x4 oa[4], z[4], so[2][3]; float l[2][3]; };
__device__ __forceinline__ void merge_load(MergeRow& R, int m, int lane, const bf16* OA, const bf16* Z, const bf16* SO, const float* LSE) {
#pragma unroll
    for (int j = 0; j < 4; ++j) { const int col = 512 * j + 8 * lane;
        R.oa[j] = __builtin_nontemporal_load((const u32x4*)(OA + (size_t)m * 2048 + col)); R.z[j] = __builtin_nontemporal_load((const u32x4*)(Z + (size_t)m * 2048 + col)); }
#pragma unroll
    for (int j = 0; j < 2; ++j) { const int col = 512 * j + 8 * lane, head = col >> 7;
#pragma unroll
        for (int g = 0; g < 3; ++g) { R.l[j][g] = LSE[((size_t)g * M + m) * 8 + head]; R.so[j][g] = __builtin_nontemporal_load((const u32x4*)(SO + ((size_t)g * M + m) * 1024 + col)); } }
}
__device__ __forceinline__ void merge_finish(const MergeRow& R, int m, int lane, const float* o_gain, bf16* OAN, bf16* OB) {
#pragma unroll
    for (int j = 0; j < 4; ++j) { const int col = 512 * j + 8 * lane;
        float o[8], z[8]; unpack8(R.oa[j], o); unpack8(R.z[j], z);
        float ss = 0.f;
#pragma unroll
        for (int e = 0; e < 8; ++e) ss += o[e] * o[e];
        ss += __shfl_xor(ss, 1); ss += __shfl_xor(ss, 2); ss += __shfl_xor(ss, 4); ss += __shfl_xor(ss, 8);
        const float rstd = rsqrtf(ss * (1.f / 128.f) + EPS);
        const float* gp = o_gain + (col & 127);
#pragma unroll
        for (int e = 0; e < 8; ++e) o[e] = o[e] * rstd * gp[e] * silu_(z[e]);
        *(u32x4*)(OAN + (size_t)m * (CATAB ? 3072 : 2048) + col) = pack8(o); }
#pragma unroll
    for (int j = 0; j < 2; ++j) { const int col = 512 * j + 8 * lane;
        const float l0 = R.l[j][0], l1 = R.l[j][1], l2 = R.l[j][2];
        const float mx = fmaxf(l0, fmaxf(l1, l2)); float a0 = fexp(l0 - mx), a1 = fexp(l1 - mx), a2 = fexp(l2 - mx); const float rs = __builtin_amdgcn_rcpf(a0 + a1 + a2); a0 *= rs; a1 *= rs; a2 *= rs;
        float o0[8], o1[8], o2[8]; unpack8(R.so[j][0], o0); unpack8(R.so[j][1], o1); unpack8(R.so[j][2], o2);
#pragma unroll
        for (int e = 0; e < 8; ++e) o0[e] = a0 * o0[e] + a1 * o1[e] + a2 * o2[e];
        *(u32x4*)(OB + (size_t)m * (CATAB ? 3072 : 1024) + col) = pack8(o0); }
}
__device__ __forceinline__ void phase_merge(Frame& F) {
    const int gw = F.vcu * NWAVES + F.wave, NGW = F.G * NWAVES, lane = F.lane;
    const bf16* OA = WSP(bf16, WS_OA); const bf16* Z = WSP(bf16, WS_Z); bf16* OAN = WSP(bf16, WS_OAN);
    const bf16* SO = WSP(bf16, WS_SWAO); const float* LSE = WSP(float, WS_LSE); bf16* OB = CATAB ? OAN + 2048 : WSP(bf16, WS_OB); const float* o_gain = karg<I_OGAIN>();
    MergeRow Ra, Rb;
    if (gw < M) merge_load(Ra, gw, lane, OA, Z, SO, LSE);
    for (int m = gw; m < M; m += 2 * NGW) {
        if (m + NGW < M) merge_load(Rb, m + NGW, lane, OA, Z, SO, LSE);
        merge_finish(Ra, m, lane, o_gain, OAN, OB);
        if (m + NGW < M) { if (m + 2 * NGW < M) merge_load(Ra, m + 2 * NGW, lane, OA, Z, SO, LSE);
            merge_finish(Rb, m + NGW, lane, o_gain, OAN, OB); }
    }
}


struct Args { const void* in[19]; float* out; unsigned char* ws; int ph_lo, ph_hi; };
#ifndef PG8_ALIGN
#define PG8_ALIGN true
#endif
#ifndef PG8_SP2
#define PG8_SP2 true
#endif
#ifndef STG2
#define STG2 0
#endif
#ifndef STG10
#define STG10 0
#endif
#ifndef STG12
#define STG12 0
#endif
#ifndef STGMODE
#define STGMODE 0
#endif
template <int Q> __device__ __forceinline__ void xcd_skew() { if (Q > 0) { const int n = Q * (STGMODE == 0 ? (int)(blockIdx.x & 7) : (int)((blockIdx.x >> 3) & 3)); for (int i = 0; i < n; ++i) __builtin_amdgcn_s_sleep(32); } }
__global__ void __launch_bounds__(NTHR, 2) mega_fwd(Args args) {
    extern __shared__ __attribute__((aligned(16))) unsigned char lds_raw[];
    Frame F;
    F.lds = (LAS unsigned char*)lds_raw;
    F.tid = threadIdx.x; F.lane = F.tid & 63; F.wave = __builtin_amdgcn_readfirstlane(F.tid >> 6);
    F.G = gridDim.x; { const int bx = blockIdx.x; F.vcu = (F.G % 8 == 0) ? (bx % 8) * (F.G / 8) + bx / 8 : bx; }
    F.out = args.out; F.ws = args.ws;
    volatile LAS unsigned* MISC = (volatile LAS unsigned*)(F.lds + MISC_OFF);
    if (F.tid < 64) MISC[F.tid] = 0u;
    __syncthreads();
    unsigned* barw = (unsigned*)(F.ws + WS_CTL) + CW_BAR;
    XcdBarrier bar; bar.bar = barw; bar.x = 0; bar.st = nullptr;
    const int lo = args.ph_lo, hi = args.ph_hi;
    if (hi - lo > 1) bar = xcd_barrier_post(barw, MISC + 8);
#ifndef PH_MASK
#define PH_MASK 0x1FFF
#endif
#define IN(k) (((PH_MASK >> (k)) & 1) && lo <= (k) && (k) < hi)
#ifndef PH_REP
#define PH_REP 0
#endif
#define REPS(k) (1 + ((PH_REP >> (k)) & 1))
#define SEAM(k) do { if ((k) != 6 && IN(k) && IN((k) + 1 + ((k) == 10))) xcd_barrier(bar); } while (0)
    const float* mod = WSP(float, WS_MOD);

    if (IN(0)) _Pragma("unroll") for (int rep = 0; rep < REPS(0); ++rep) { __syncthreads(); phase0(F); } SEAM(0);
    if (IN(1)) _Pragma("unroll") for (int rep = 0; rep < REPS(1); ++rep) { __syncthreads(); phase_norm_mod<true, I8_PROJ != 0>(F, karg<I_X>(), 0, 1, WSP(bf16, WS_H), WSP(float, WS_SA_IN)); phase_quant_weights(F); } SEAM(1);
    if (IN(2)) _Pragma("unroll") for (int rep = 0; rep < REPS(2); ++rep) { __syncthreads();
        typedef pg8::EpiProj<I8_PROJ != 0> EP; typedef std::conditional<I8_PROJ != 0, pg8::MmaI8, pg8::MmaBf16>::type MM;
        constexpr int NPROJ = I8_PROJ ? N_IN_PAD - 256 : N_IN_PAD;
        pg8::Gemm g{WSP(pg8::bf16_t, WS_H), WSP(pg8::bf16_t, WS_BT_IN), M, NPROJ, I8_PROJ ? D / 2 : D}; pg8::StaticOrder S; S.init(M, NPROJ, F.G, (int)blockIdx.x);
        EP E{F.ws, WS_QKVA, WS_Z, WS_QKVB, WS_GATES, WS_BG, WS_SMALL, WS_SA_IN, WS_SB_IN};
#ifdef PROBE_NULL2
        { pg8::EpiNull EN; pg8::gemm_phase<pg8::EpiNull, pg8::StaticOrder, PG8_ALIGN, PG8_SP2, pg8::AMapNat, MM>(F.lds, g, S, EN); __syncthreads(); }
#endif
#ifdef PROBE_R1
        { typedef pg8::EpiProj<I8_PROJ != 0, PROBE_R1> EPF; EPF EF{F.ws, WS_QKVA, WS_Z, WS_QKVB, WS_GATES, WS_BG, WS_SMALL, WS_SA_IN, WS_SB_IN};
          pg8::gemm_phase<EPF, pg8::StaticOrder, PG8_ALIGN, PG8_SP2, pg8::AMapNat, MM>(F.lds, g, S, EF); __syncthreads(); }
#endif
#ifdef PROBE_R0
        { pg8::gemm_phase<EP, pg8::StaticOrder, PG8_ALIGN, PG8_SP2, pg8::AMapNat, MM>(F.lds, g, S, E); __syncthreads(); }
#endif
#ifdef PROBE_SCR2
        {
#ifdef PROBE_FRESH
        pg8::EpiScratch EN{F.ws, WS_RB};
#else
        pg8::EpiScratch EN{F.ws, WS_RC};
#endif
        pg8::gemm_phase<pg8::EpiScratch, pg8::StaticOrder, PG8_ALIGN, PG8_SP2, pg8::AMapNat, MM>(F.lds, g, S, EN); __syncthreads(); }
#endif
        xcd_skew<STG2>();
        pg8::gemm_phase<EP, pg8::StaticOrder, PG8_ALIGN, PG8_SP2, pg8::AMapNat, MM>(F.lds, g, S, E);
        if (I8_PROJ) phase_bg_mini(F);
    } SEAM(2);
    if (IN(3)) _Pragma("unroll") for (int rep = 0; rep < REPS(3); ++rep) { __syncthreads(); __syncthreads(); { int cached_h = -1; for (int ci = F.vcu; ci < 4096; ci += F.G) d1_item(F, ci, cached_h); } } SEAM(3);
    if (IN(4)) _Pragma("unroll") for (int rep = 0; rep < REPS(4); ++rep) { __syncthreads();
        __syncthreads();
        if (F.vcu < 64) { _Pragma("unroll") for (int r2 = 0; r2 < REPS(13); ++r2) d2_item(F, F.vcu); } else { _Pragma("unroll") for (int r2 = 0; r2 < REPS(14); ++r2) for (int u = F.vcu - 64; u < 3072; u += F.G - 64) swa_unit(F, u); }
    } SEAM(4);
    if (IN(5)) _Pragma("unroll") for (int rep = 0; rep < REPS(5); ++rep) { __syncthreads(); phase_merge(F); } SEAM(5);
#if CATAB
    if (IN(6)) { __syncthreads();
        pg8::Gemm g{WSP(pg8::bf16_t, WS_OAN), WSP(pg8::bf16_t, WS_BT_A), M, D, 3072}; pg8::StaticOrder S; S.init(M, D, F.G, (int)blockIdx.x);
        pg8::EpiGatedCat E{WSP(pg8::bf16_t, WS_TM), WSP(pg8::bf16_t, WS_GATES), I8_O ? (unsigned*)(F.ws + WS_RM_O) : nullptr};
        pg8::gemm_phase<pg8::EpiGatedCat, pg8::StaticOrder, PG8_ALIGN, PG8_SP2, pg8::AMapNat, pg8::MmaBf16, 32>(F.lds, g, S, E);
    } SEAM(7);
#else
    if (IN(6)) _Pragma("unroll") for (int rep = 0; rep < REPS(6); ++rep) { __syncthreads();
        pg8::Gemm g{WSP(pg8::bf16_t, WS_OAN), WSP(pg8::bf16_t, WS_BT_A), M, D, 2048}; pg8::StaticOrder S; S.init(M, D, F.G, (int)blockIdx.x);
        pg8::EpiGated<0> E{WSP(pg8::bf16_t, WS_TM), WSP(pg8::bf16_t, WS_GATES), 0, nullptr};
        pg8::gemm_phase<pg8::EpiGated<0>, pg8::StaticOrder, PG8_ALIGN, PG8_SP2>(F.lds, g, S, E);
    } SEAM(6);
    if (IN(7)) _Pragma("unroll") for (int rep = 0; rep < REPS(7); ++rep) { __syncthreads();
        pg8::Gemm g{WSP(pg8::bf16_t, WS_OB), WSP(pg8::bf16_t, WS_BT_B), M, D, 1024}; pg8::StaticOrder S; S.init(M, D, F.G, (int)blockIdx.x);
        pg8::EpiGated<1> E{WSP(pg8::bf16_t, WS_TM), WSP(pg8::bf16_t, WS_GATES), 4096, I8_O ? (unsigned*)(F.ws + WS_RM_O) : nullptr};
        pg8::gemm_phase<pg8::EpiGated<1>, pg8::StaticOrder, PG8_ALIGN, PG8_SP2>(F.lds, g, S, E);
    } SEAM(7);
#endif
    if (IN(8)) _Pragma("unroll") for (int rep = 0; rep < REPS(8); ++rep) { __syncthreads();
#if X1B
        typedef pg8::EpiResidP<I8_O != 0, 0> ER;
#else
        typedef pg8::EpiResid<I8_O != 0> ER;
#endif
        typedef std::conditional<I8_O != 0, pg8::MmaI8, pg8::MmaBf16>::type MO;
        if (I8_O) { phase_quant_rows(F); xcd_barrier(bar); }
        pg8::Gemm g{I8_O ? WSP(pg8::bf16_t, WS_TMQ) : WSP(pg8::bf16_t, WS_TM), WSP(pg8::bf16_t, WS_BT_O), M, D, I8_O ? D / 2 : D}; pg8::StaticOrder S; S.init(M, D, F.G, (int)blockIdx.x);
#if X1B
        ER E{karg<I_X>(), F.ws + WS_X1B, mod + 2 * D, WSP(float, WS_SA_O), WSP(float, WS_SB_O)};
#else
        ER E{karg<I_X>(), F.out, mod + 2 * D, WSP(float, WS_SA_O), WSP(float, WS_SB_O)};
#endif
        pg8::gemm_phase<ER, pg8::StaticOrder, PG8_ALIGN, PG8_SP2, pg8::AMapNat, MO>(F.lds, g, S, E);
    } SEAM(8);
#if X1B
    if (IN(9)) _Pragma("unroll") for (int rep = 0; rep < REPS(9); ++rep) { __syncthreads(); phase_norm_mod_b16(F, WSP(bf16, WS_X1B), 3, 4, WSP(bf16, WS_H2)); } SEAM(9);
#else
    if (IN(9)) _Pragma("unroll") for (int rep = 0; rep < REPS(9); ++rep) { __syncthreads(); phase_norm_mod<false, I8_UP != 0>(F, F.out, 3, 4, WSP(bf16, WS_H2), WSP(float, WS_SA_UP)); } SEAM(9);
#endif
    if (IN(10)) _Pragma("unroll") for (int rep = 0; rep < REPS(10); ++rep) { __syncthreads();
        typedef pg8::EpiUpConv<I8_UP != 0> EU; typedef std::conditional<I8_UP != 0, pg8::MmaI8, pg8::MmaBf16>::type MU;
        pg8::Gemm g{WSP(pg8::bf16_t, WS_H2), WSP(pg8::bf16_t, WS_BT_UP), 65 * 256, 2 * DFF, I8_UP ? D / 2 : D}; pg8::StaticOrder S; S.init(65 * 256, 2 * DFF, F.G, (int)blockIdx.x);
        EU E{WSP(pg8::bf16_t, WS_ACT), karg<I_CONVFFN>(), (PG8_LAS float*)(F.lds + XL_OFF), WSP(float, WS_SA_UP), WSP(float, WS_SB_UP), M};
        xcd_skew<STG10>();
        pg8::gemm_phase<EU, pg8::StaticOrder, true, PG8_SP2, pg8::AMapConv, MU>(F.lds, g, S, E);
    } SEAM(10);
    if (IN(12)) _Pragma("unroll") for (int rep = 0; rep < REPS(12); ++rep) { __syncthreads();
        pg8::Gemm g{WSP(pg8::bf16_t, WS_ACT), WSP(pg8::bf16_t, WS_BT_DN), M, D, DFF}; pg8::StaticOrder S; S.init(M, D, F.G, (int)blockIdx.x);
#if X1B
        pg8::EpiResidP<false, 1> E{F.ws + WS_X1B, F.out, mod + 5 * D, nullptr, nullptr};
        pg8::gemm_phase<pg8::EpiResidP<false, 1>, pg8::StaticOrder, PG8_ALIGN, PG8_SP2>(F.lds, g, S, E);
#else
        pg8::EpiResid<false> E{F.out, (REPS(12) > 1 && rep == 0) ? WSP(float, WS_RA) : F.out, mod + 5 * D, nullptr, nullptr};
        xcd_skew<STG12>();
        pg8::gemm_phase<pg8::EpiResid<false>, pg8::StaticOrder, PG8_ALIGN, PG8_SP2>(F.lds, g, S, E);
#endif
    }
#undef IN
#undef SEAM
}

extern "C" void kernel_launch(void* const* d_in, const int* in_sizes, int n_in, void* d_out, int out_size, void* d_ws, size_t ws_size, hipStream_t stream) {
    static int grid = 0;
    if (grid == 0) {
        if (n_in != 19 || in_sizes[0] != M * D || out_size != M * D || ws_size < WS_END) { fprintf(stderr, "kernel_launch: unexpected shapes / workspace (n_in %d, in0 %d, out %d, ws %zu < %zu); nothing launched\n", n_in, n_in > 0 ? in_sizes[0] : -1, out_size, ws_size, (size_t)WS_END); grid = -1; return; }
        int dev = 0, cus = 0, per_cu = 0;
        if (hipGetDevice(&dev) != hipSuccess || hipDeviceGetAttribute(&cus, hipDeviceAttributeMultiprocessorCount, dev) != hipSuccess) { grid = -1; return; }
        if (hipFuncSetAttribute((const void*)mega_fwd, hipFuncAttributeMaxDynamicSharedMemorySize, LDS_BYTES) != hipSuccess) { fprintf(stderr, "kernel_launch: hipFuncSetAttribute failed\n"); grid = -1; return; }
        if (hipOccupancyMaxActiveBlocksPerMultiprocessor(&per_cu, (const void*)mega_fwd, NTHR, LDS_BYTES) != hipSuccess || per_cu < 1) { fprintf(stderr, "kernel_launch: occupancy query reports %d blocks per CU\n", per_cu); }
        (void)hipGetLastError();
        grid = cus;
        if (grid <= 64) { fprintf(stderr, "kernel_launch: needs more than 64 CUs (got %d); nothing launched\n", grid); grid = -1; return; }
    }
    if (grid < 0) return;
    if (hipMemsetAsync((char*)d_ws + WS_CTL, 0, CTL_ZERO_BYTES, stream) != hipSuccess) { fprintf(stderr, "kernel_launch: memset failed\n"); return; }
    Args a{};
    for (int i = 0; i < 19; ++i) a.in[i] = d_in[i];
    a.out = (float*)d_out; a.ws = (unsigned char*)d_ws;
    a.ph_lo = 0; a.ph_hi = N_PHASES;
    hipLaunchKernelGGL(mega_fwd, dim3(grid), dim3(NTHR), LDS_BYTES, stream, a);
    const hipError_t le = hipPeekAtLastError();
    if (le != hipSuccess) fprintf(stderr, "kernel_launch: launch failed: %s\n", hipGetErrorName(le));
}
```

```cpp
#include <hip/hip_runtime.h>
#include <cstdio>
#include <cstdint>
#include <type_traits>
namespace pg8 {
#define PG8_LAS __attribute__((address_space(3)))
typedef unsigned short bf16_t;
typedef short bf16x8 __attribute__((ext_vector_type(8)));
typedef float f32x4 __attribute__((ext_vector_type(4)));
typedef unsigned u32x4 __attribute__((ext_vector_type(4)));
constexpr int BM = 256, BK = 64, HALF = 128, HTB = HALF * BK * 2  , STAGE_BYTES = 8 * HTB, NXCD = 8, WGM = 8;

__host__ __device__ __forceinline__ int lds_byte(int r, int c) { const int st = (r >> 4) * 2 + (c >> 5), rr = r & 15, cc = c & 31, ob = rr * 64 + cc * 2; return st * 1024 + (ob ^ (((ob >> 9) & 1) << 5)); }
__host__ __device__ __forceinline__ void stage_rc(int b, int& R, int& C) { const int st = b / 1024, sb = b % 1024, swz = sb ^ (((sb >> 9) & 1) << 5); R = (st >> 1) * 16 + swz / 64; C = (st & 1) * 32 + (swz % 64) / 2; }
__host__ __device__ __forceinline__ int perm32(int rho) { const int n = rho >> 4, i = rho & 15; return 8 * (i >> 2) + 4 * n + (i & 3); }

struct Unit { int pm, pn; };
struct Gemm { const bf16_t* A; const bf16_t* Bt; int M, N, K; };

struct StaticOrder {
    int nM, nN, nwg, G, c;
    __host__ __device__ void init(int M, int N, int G_, int c_) { nM = M / BM; nN = N / BM; nwg = nM * nN; G = G_; c = c_; }
    __host__ __device__ bool next(int i, Unit& u) const {
        const long L = (long)i * G + c; if (L >= nwg) return false;
        int wgid = (int)L; { const int q = nwg / NXCD, r = nwg % NXCD, xcd = wgid % NXCD, off = wgid / NXCD; wgid = (xcd < r ? xcd * (q + 1) : r * (q + 1) + (xcd - r) * q) + off; }
        const int ngrp = nM >= WGM ? nM / WGM : 1, nig = WGM * nN; int gid = wgid / nig; if (gid >= ngrp) gid = ngrp - 1;
        const int fm = gid * WGM, gsz = (gid == ngrp - 1) ? (nM - fm) : WGM, loc = wgid - gid * nig;
        u.pm = fm + (loc % gsz); u.pn = loc / gsz; return true;
    }
    __device__ __forceinline__ void a_ready(const Unit&) const {}
    __device__ __forceinline__ void done(const Unit&) const {}
};

__device__ __forceinline__ unsigned cvt_pk_bf16(float lo, float hi) { unsigned r; asm volatile("v_cvt_pk_bf16_f32 %0, %1, %2" : "=v"(r) : "v"(lo), "v"(hi)); return r; }
__device__ __forceinline__ float fexp(float x) { return __builtin_amdgcn_exp2f(x * 1.4426950408889634f); }
__device__ __forceinline__ float bflo(unsigned w) { return __uint_as_float(w << 16); }
__device__ __forceinline__ float bfhi(unsigned w) { return __uint_as_float(w & 0xffff0000u); }
__device__ __forceinline__ float sigmoidf_(float x) { return __builtin_amdgcn_rcpf(1.0f + fexp(-x)); }
__device__ __forceinline__ float softplusf_(float x) { return fmaxf(x, 0.f) + log1pf(fexp(-fabsf(x))); }


struct AMapNat {
    __device__ static __forceinline__ int voff(int R, int C, int K) { return (R * K + C) * 2; }
    __device__ static __forceinline__ size_t hstep(int K) { return (size_t)HALF * K * 2; }
    __device__ static __forceinline__ size_t tstep(int K) { return (size_t)BM * K * 2; }
};
struct AMapConv {
    __device__ static __forceinline__ int voff(int R, int C, int K) { const int wr = R >> 6, m = (R >> 4) & 3, fr = R & 15; return ((128 * wr - 2 + 8 * fr + m) * K + C) * 2; }
    __device__ static __forceinline__ size_t hstep(int K) { return (size_t)4 * K * 2; }
    __device__ static __forceinline__ size_t tstep(int K) { return (size_t)254 * K * 2; }
};
typedef int i32x4 __attribute__((ext_vector_type(4)));
struct MmaBf16 { typedef f32x4 acc_t; __device__ static __forceinline__ acc_t zero() { return (f32x4){0.f, 0.f, 0.f, 0.f}; }
    __device__ static __forceinline__ acc_t mma(bf16x8 b, bf16x8 a, acc_t c) { return __builtin_amdgcn_mfma_f32_16x16x32_bf16(b, a, c, 0, 0, 0); } };
struct MmaI8 { typedef i32x4 acc_t; __device__ static __forceinline__ acc_t zero() { return (i32x4){0, 0, 0, 0}; }
    __device__ static __forceinline__ acc_t mma(bf16x8 b, bf16x8 a, acc_t c) { return __builtin_amdgcn_mfma_i32_16x16x64_i8(__builtin_bit_cast(i32x4, b), __builtin_bit_cast(i32x4, a), c, 0, 0, 0); } };

struct EpiBf16Plain {
    static constexpr bool PERM = true, AFTER_DRAIN = false; static constexpr int NSTORE = 16;
    bf16_t* O; int ldc;
    __device__ __forceinline__ void operator()(const f32x4 (&acc)[2][2][4][2], const Unit& u, int wr, int wc, int fr, int fq) const {
        const int row0 = u.pm * BM + wr * 64 + fr, col0 = u.pn * BM + wc * 32 + 8 * fq;
#ifdef PROBE_NOSTORE
        if (O == nullptr) {
#pragma unroll
            for (int ai = 0; ai < 2; ++ai)
#pragma unroll
                for (int m = 0; m < 4; ++m)
#pragma unroll
                    for (int bj = 0; bj < 2; ++bj) asm volatile("" :: "v"(acc[ai][bj][m][0]), "v"(acc[ai][bj][m][1]));
            return; }
#endif
#pragma unroll
        for (int ai = 0; ai < 2; ++ai)
#pragma unroll
            for (int m = 0; m < 4; ++m) { bf16_t* rowp = O + (size_t)(row0 + ai * HALF + m * 16) * ldc + col0;
#pragma unroll
                for (int bj = 0; bj < 2; ++bj) { const f32x4 v0 = acc[ai][bj][m][0], v1 = acc[ai][bj][m][1];
                    u32x4 w; w.x = cvt_pk_bf16(v0[0], v0[1]); w.y = cvt_pk_bf16(v0[2], v0[3]); w.z = cvt_pk_bf16(v1[0], v1[1]); w.w = cvt_pk_bf16(v1[2], v1[3]);
                    *(u32x4*)(rowp + bj * HALF) = w; } }
    }
};


__device__ __forceinline__ float dpp_shr1(float x) { return __builtin_bit_cast(float, __builtin_amdgcn_update_dpp(0, __builtin_bit_cast(int, x), 0x111, 0xf, 0xf, true)); }
template <bool I8> struct EpiUpConv {
    static constexpr bool PERM = true, AFTER_DRAIN = false; static constexpr int NSTORE = 0;
    bf16_t* ACT; const float* conv; PG8_LAS float* xl; const float* sA; const float* sB; int Mtok;
    typedef float f32x2 __attribute__((ext_vector_type(2)));
    template <class ACC> __device__ __forceinline__ void body(const ACC (&acc)[2][2][4][2], const Unit& u, int wc, int fq, int tok0, const float (&sa)[8], bool from_lds, const PG8_LAS float* xs, const f32x4 (&cw)[3][2][2], const float (&m1)[8], const float (&m2)[8], unsigned (&outw)[8][4]) const {
#pragma unroll
        for (int n = 0; n < 2; ++n)
#pragma unroll
            for (int ep = 0; ep < 2; ++ep) { const int e0 = 2 * ep, c0 = 4 * n + e0;
                f32x2 g[8], v[8];
                f32x2 sg = (f32x2){1.f, 1.f}, sv = sg;
                if (I8) { const float* sbp = sB + 256 * u.pn + 32 * wc + 8 * fq + c0; sg = (f32x2){sbp[0], sbp[1]}; sv = (f32x2){sbp[128], sbp[129]}; }
#pragma unroll
                for (int j = 0; j < 8; ++j) { g[j] = (f32x2){(float)acc[j >> 2][0][j & 3][n][e0], (float)acc[j >> 2][0][j & 3][n][e0 + 1]}; v[j] = (f32x2){(float)acc[j >> 2][1][j & 3][n][e0], (float)acc[j >> 2][1][j & 3][n][e0 + 1]};
                    if (I8) { g[j] = g[j] * sg * sa[j]; v[j] = v[j] * sv * sa[j]; } }
                f32x2 gm1 = (f32x2){dpp_shr1(g[7].x), dpp_shr1(g[7].y)}, gm2 = (f32x2){dpp_shr1(g[6].x), dpp_shr1(g[6].y)}, vm1 = (f32x2){dpp_shr1(v[7].x), dpp_shr1(v[7].y)}, vm2 = (f32x2){dpp_shr1(v[6].x), dpp_shr1(v[6].y)};
                {
                  f32x2 l0, l1, l2, l3; const unsigned xa = (unsigned)(size_t)(xs + c0);
                  asm volatile("ds_read_b64 %0, %4\n\tds_read_b64 %1, %4 offset:32\n\tds_read_b64 %2, %4 offset:64\n\tds_read_b64 %3, %4 offset:96\n\ts_waitcnt lgkmcnt(0)" : "=&v"(l0), "=&v"(l1), "=&v"(l2), "=&v"(l3) : "v"(xa) : "memory");
                  if (from_lds) { gm2 = l0; gm1 = l1; vm2 = l2; vm1 = l3; } }
                const f32x2 w0 = (f32x2){cw[0][0][n][e0], cw[0][0][n][e0 + 1]}, w1 = (f32x2){cw[1][0][n][e0], cw[1][0][n][e0 + 1]}, w2 = (f32x2){cw[2][0][n][e0], cw[2][0][n][e0 + 1]};
                const f32x2 u0 = (f32x2){cw[0][1][n][e0], cw[0][1][n][e0 + 1]}, u1 = (f32x2){cw[1][1][n][e0], cw[1][1][n][e0 + 1]}, u2 = (f32x2){cw[2][1][n][e0], cw[2][1][n][e0 + 1]};
#pragma unroll
                for (int j = 0; j < 8; ++j) {
                    f32x2 x1 = j >= 1 ? g[j - 1] : gm1, x2 = j >= 2 ? g[j - 2] : (j == 1 ? gm1 : gm2);
                    f32x2 y1 = j >= 1 ? v[j - 1] : vm1, y2 = j >= 2 ? v[j - 2] : (j == 1 ? vm1 : vm2);
                    x1 = x1 * m1[j]; y1 = y1 * m1[j]; x2 = x2 * m2[j]; y2 = y2 * m2[j];
                    const f32x2 cg = w0 * x2 + w1 * x1 + w2 * g[j], cv = u0 * y2 + u1 * y1 + u2 * v[j];
                    f32x2 dn; dn.x = 1.0f + fexp(-cg.x); dn.y = 1.0f + fexp(-cg.y);
                    f32x2 rc; rc.x = __builtin_amdgcn_rcpf(dn.x); rc.y = __builtin_amdgcn_rcpf(dn.y);
                    const f32x2 a = cg * rc * cv;
                    outw[j][2 * n + ep] = cvt_pk_bf16(a.x, a.y); }
            }
    }
    template <class ACC> __device__ __forceinline__ void operator()(const ACC (&acc)[2][2][4][2], const Unit& u, int wr, int wc, int fr, int fq) const {
        const int tok0 = 254 * u.pm - 2 + 128 * wr + 8 * fr;
        const int jc = 128 * u.pn + 32 * wc + 8 * fq;
        f32x4 cw[3][2][2];
#pragma unroll
        for (int t = 0; t < 3; ++t)
#pragma unroll
            for (int gv = 0; gv < 2; ++gv)
#pragma unroll
                for (int n = 0; n < 2; ++n) cw[t][gv][n] = *(const f32x4*)(conv + t * 22016 + gv * 11008 + jc + 4 * n);
        float sa[8];
#pragma unroll
        for (int j = 0; j < 8; ++j) { const int t = tok0 + j; sa[j] = (I8 && t >= 0 && t < Mtok) ? sA[t] : 0.f; }
        PG8_LAS float* xs = xl + (wc * 4 + fq) * 32;
        if (wr == 0 && fr == 15) {
            f32x4 q[8];
#pragma unroll
            for (int n = 0; n < 2; ++n)
#pragma unroll
                for (int e = 0; e < 4; ++e) {
                    float g6 = (float)acc[1][0][2][n][e], g7 = (float)acc[1][0][3][n][e], v6 = (float)acc[1][1][2][n][e], v7 = (float)acc[1][1][3][n][e];
                    if (I8) { const float sg = sB[256 * u.pn + 32 * wc + 8 * fq + 4 * n + e], sv = sB[256 * u.pn + 128 + 32 * wc + 8 * fq + 4 * n + e]; g6 *= sa[6] * sg; g7 *= sa[7] * sg; v6 *= sa[6] * sv; v7 *= sa[7] * sv; }
                    q[n][e] = g6; q[2 + n][e] = g7; q[4 + n][e] = v6; q[6 + n][e] = v7; }
            const unsigned wa = (unsigned)(size_t)xs;
            asm volatile("ds_write_b128 %0, %1\n\tds_write_b128 %0, %2 offset:16\n\tds_write_b128 %0, %3 offset:32\n\tds_write_b128 %0, %4 offset:48\n\tds_write_b128 %0, %5 offset:64\n\tds_write_b128 %0, %6 offset:80\n\tds_write_b128 %0, %7 offset:96\n\tds_write_b128 %0, %8 offset:112\n\ts_waitcnt lgkmcnt(0)"
                         :: "v"(wa), "v"(q[0]), "v"(q[1]), "v"(q[2]), "v"(q[3]), "v"(q[4]), "v"(q[5]), "v"(q[6]), "v"(q[7]) : "memory");
        }
        asm volatile("s_waitcnt lgkmcnt(0)" ::: "memory"); __builtin_amdgcn_s_barrier(); asm volatile("" ::: "memory");
        const bool from_lds = (wr == 1 && fr == 0);
        float m1[8], m2[8];
#pragma unroll
        for (int j = 0; j < 8; ++j) { const int p = (tok0 + j) & 4095; m1[j] = p < 1 ? 0.f : 1.f; m2[j] = p < 2 ? 0.f : 1.f; }
        unsigned outw[8][4];
        body(acc, u, wc, fq, tok0, sa, from_lds, xs, cw, m1, m2, outw);
#pragma unroll
        for (int j = 0; j < 8; ++j) { const int t = tok0 + j; const bool ok = (t >= 0) && (t < Mtok) && !(wr == 0 && fr == 0 && j < 2);
            if (ok) { u32x4 w; w.x = outw[j][0]; w.y = outw[j][1]; w.z = outw[j][2]; w.w = outw[j][3]; *(u32x4*)(ACT + (size_t)t * 11008 + jc) = w; } }
    }
};

struct EpiNull {
    static constexpr bool PERM = true, AFTER_DRAIN = false; static constexpr int NSTORE = 0;
    template <class ACC> __device__ __forceinline__ void operator()(const ACC (&acc)[2][2][4][2], const Unit& u, int wr, int wc, int fr, int fq) const {
#pragma unroll
        for (int ai = 0; ai < 2; ++ai)
#pragma unroll
            for (int m = 0; m < 4; ++m)
#pragma unroll
                for (int bj = 0; bj < 2; ++bj) asm volatile("" :: "v"(acc[ai][bj][m][0]), "v"(acc[ai][bj][m][1]));
    }
};
struct EpiScratch {
    static constexpr bool PERM = true, AFTER_DRAIN = false; static constexpr int NSTORE = 0;
    unsigned char* ws; size_t off;
    template <class ACC> __device__ __forceinline__ void operator()(const ACC (&acc)[2][2][4][2], const Unit& u, int wr, int wc, int fr, int fq) const {
        const int row0 = wr * 64 + fr, col0 = wc * 32 + 8 * fq;
#ifdef PROBE_COAL
#ifdef PROBE_FRESH
        unsigned char* wb = ws + off + (size_t)(u.pn * 64 + u.pm) * 131072 + (size_t)__builtin_amdgcn_readfirstlane(wr * 4 + wc) * 16384;
#else
        unsigned char* wb = ws + off + (size_t)blockIdx.x * 131072 + (size_t)__builtin_amdgcn_readfirstlane(wr * 4 + wc) * 16384;
#endif
#ifdef PROBE_HALFWG
        const bool st_on = ((blockIdx.x >> 3) & 1) == 0;
#else
        const bool st_on = true;
#endif
        unsigned lo; asm volatile("v_mbcnt_lo_u32_b32 %0, -1, 0\n\tv_mbcnt_hi_u32_b32 %0, -1, %0\n\tv_lshlrev_b32 %0, 4, %0" : "=v"(lo));
        bf16_t* O = nullptr; (void)O;
#else
        bf16_t* O = (bf16_t*)(ws + off + (size_t)blockIdx.x * 131072) + row0 * 256 + col0;
#endif
#pragma unroll
        for (int ai = 0; ai < 2; ++ai)
#pragma unroll
#ifdef PROBE_COAL
            for (int m = 0; m < 4; ++m) { unsigned char* rowp = wb + (ai * 4 + m) * 2048;
#else
            for (int m = 0; m < 4; ++m) { bf16_t* rowp = O + (ai * HALF + m * 16) * 256;
#endif
#pragma unroll
                for (int bj = 0; bj < 2; ++bj) { f32x4 v0, v1;
#pragma unroll
                    for (int e = 0; e < 4; ++e) { v0[e] = (float)acc[ai][bj][m][0][e]; v1[e] = (float)acc[ai][bj][m][1][e]; }
                    u32x4 w; w.x = cvt_pk_bf16(v0[0], v0[1]); w.y = cvt_pk_bf16(v0[2], v0[3]); w.z = cvt_pk_bf16(v1[0], v1[1]); w.w = cvt_pk_bf16(v1[2], v1[3]);
#ifdef PROBE_HALF
                    if (ai == 0) *(u32x4*)(rowp + bj * 1024 + lo) = w; else asm volatile("" :: "v"(w)); } }
#elif defined(PROBE_COAL)
                    if (st_on) *(u32x4*)(rowp + bj * 1024 + lo) = w; else asm volatile("" :: "v"(w)); } }
#else
                    *(u32x4*)(rowp + bj * HALF) = w; } }
#endif
    }
};
template <bool I8, int FAKE = 0> struct EpiProj {
    static constexpr bool PERM = true, AFTER_DRAIN = false; static constexpr int NSTORE = (I8 && FAKE == 0) ? 16 : 0;
    unsigned char* ws; size_t o_qkva, o_z, o_qkvb, o_gates, o_bg, o_small, o_sa, o_sb;
    template <class ACC> __device__ __forceinline__ void operator()(const ACC (&acc)[2][2][4][2], const Unit& u, int wr, int wc, int fr, int fq) const {
        const int row0 = u.pm * BM + wr * 64 + fr;
        const int pn = u.pn;
        const float* small = (const float*)(ws + o_small);
        const float* sA = (const float*)(ws + o_sa); const float* sB = (const float*)(ws + o_sb) + pn * 256 + wc * 32 + 8 * fq;
        if (pn < 100) {
            float sa[2][4]; f32x4 s0[2], s1[2], b0[2], b1[2];
#pragma unroll
            for (int bj = 0; bj < 2; ++bj) { s0[bj] = (f32x4){1.f, 1.f, 1.f, 1.f}; s1[bj] = s0[bj]; b0[bj] = (f32x4){0.f, 0.f, 0.f, 0.f}; b1[bj] = b0[bj]; }
            if (I8) {
#pragma unroll
                for (int ai = 0; ai < 2; ++ai)
#pragma unroll
                    for (int m = 0; m < 4; ++m) sa[ai][m] = sA[row0 + ai * HALF + m * 16];
#pragma unroll
                for (int bj = 0; bj < 2; ++bj) { s0[bj] = *(const f32x4*)(sB + bj * HALF); s1[bj] = *(const f32x4*)(sB + bj * HALF + 4); }
            }
            const bool gate = pn >= 68;
            bf16_t* base; int ldc, colt;
            if (pn < 24) { base = (bf16_t*)(ws + o_qkva); ldc = 6144; colt = pn * 256; }
            else if (pn < 32) { base = (bf16_t*)(ws + o_z); ldc = 2048; colt = (pn - 24) * 256; }
            else if (pn < 68) { base = (bf16_t*)(ws + o_qkvb); ldc = 9216; colt = (pn - 32) * 256; }
            else { base = (bf16_t*)(ws + o_gates); ldc = 8192; colt = (pn - 68) * 256; }
            const int col0 = colt + wc * 32 + 8 * fq;
            if (gate) {
#pragma unroll
                for (int bj = 0; bj < 2; ++bj) { b0[bj] = *(const f32x4*)(small + col0 + bj * HALF); b1[bj] = *(const f32x4*)(small + col0 + bj * HALF + 4); }
            }
            if (I8) {
                asm volatile("" : "+v"(sa[0][0]), "+v"(sa[0][1]), "+v"(sa[0][2]), "+v"(sa[0][3]), "+v"(sa[1][0]), "+v"(sa[1][1]), "+v"(sa[1][2]), "+v"(sa[1][3]));
                asm volatile("" : "+v"(s0[0]), "+v"(s1[0]), "+v"(s0[1]), "+v"(s1[1]), "+v"(b0[0]), "+v"(b1[0]), "+v"(b0[1]), "+v"(b1[1]));
            }
#pragma unroll
            for (int bj = 0; bj < 2; ++bj) {
#pragma unroll
                for (int ai = 0; ai < 2; ++ai)
#pragma unroll
                    for (int m = 0; m < 4; ++m) { const int row = row0 + ai * HALF + m * 16; bf16_t* rowp = base + (size_t)row * ldc + col0 + bj * HALF;
                        if (FAKE == 1) rowp = (bf16_t*)(ws + o_qkva + (size_t)(u.pn * 64 + u.pm) * 131072 + (size_t)__builtin_amdgcn_readfirstlane(wr * 4 + wc) * 16384 + ((ai * 4 + m) * 2 + bj) * 1024 + (fq * 16 + fr) * 16);
                        f32x4 v0, v1;
#pragma unroll
                        for (int e = 0; e < 4; ++e) { v0[e] = (float)acc[ai][bj][m][0][e]; v1[e] = (float)acc[ai][bj][m][1][e]; }
                        if (I8) { const float a = sa[ai][m]; v0 = v0 * s0[bj] * a; v1 = v1 * s1[bj] * a; }
                        if (gate) { v0 = v0 + b0[bj]; v1 = v1 + b1[bj];
#pragma unroll
                            for (int j = 0; j < 4; ++j) { v0[j] = sigmoidf_(v0[j]); v1[j] = sigmoidf_(v1[j]); } }
                        u32x4 w; w.x = cvt_pk_bf16(v0[0], v0[1]); w.y = cvt_pk_bf16(v0[2], v0[3]); w.z = cvt_pk_bf16(v1[0], v1[1]); w.w = cvt_pk_bf16(v1[2], v1[3]);
                        *(u32x4*)rowp = w; }
            }
        } else {
            if (wc == 0) {
                float* bg = (float*)(ws + o_bg);
#pragma unroll
                for (int n = 0; n < 2; ++n) {
                    const int colb = 8 * fq + 4 * n;
                    float ea[4], db[4], sb[4];
#pragma unroll
                    for (int e = 0; e < 4; ++e) { const int hh = (colb + e) & 15; ea[e] = -fexp(small[8192 + hh]); db[e] = small[8192 + 16 + hh]; sb[e] = I8 ? sB[4 * n + e] : 1.f; }
#pragma unroll
                    for (int ai = 0; ai < 2; ++ai)
#pragma unroll
                        for (int m = 0; m < 4; ++m) { const int row = row0 + ai * HALF + m * 16; const float sa = I8 ? sA[row] : 1.f; f32x4 o;
#pragma unroll
                            for (int e = 0; e < 4; ++e) { const float v = (float)acc[ai][0][m][n][e] * (I8 ? sa * sb[e] : 1.f); o[e] = (colb < 16) ? sigmoidf_(v) : ea[e] * softplusf_(v + db[e]); }
                            *(f32x4*)(bg + (size_t)row * 32 + colb) = o; }
                }
            }
        }
    }
};

template <int MODE> struct EpiGated {
    static constexpr bool PERM = true, AFTER_DRAIN = false; static constexpr int NSTORE = 16;
    bf16_t* Tm; const bf16_t* gates; int goff; unsigned* rowmax;
    __device__ __forceinline__ void operator()(const f32x4 (&acc)[2][2][4][2], const Unit& u, int wr, int wc, int fr, int fq) const {
        const int row0 = u.pm * BM + wr * 64 + fr, col0 = u.pn * BM + wc * 32 + 8 * fq;
#pragma unroll
        for (int ai = 0; ai < 2; ++ai) {
            u32x4 g[4][2], t[4][2];
#pragma unroll
            for (int m = 0; m < 4; ++m) { const size_t row = (size_t)(row0 + ai * HALF + m * 16);
                const bf16_t* gp = gates + row * 8192 + goff + col0; const bf16_t* tp = Tm + row * 4096 + col0;
#pragma unroll
                for (int bj = 0; bj < 2; ++bj) { g[m][bj] = __builtin_nontemporal_load((const u32x4*)(gp + bj * HALF)); if (MODE == 1) t[m][bj] = *(const u32x4*)(tp + bj * HALF); } }
            float rm[4];
#pragma unroll
            for (int m = 0; m < 4; ++m) { const size_t row = (size_t)(row0 + ai * HALF + m * 16);
                bf16_t* rowp = Tm + row * 4096 + col0; float rmx = 0.f;
#pragma unroll
                for (int bj = 0; bj < 2; ++bj) { const f32x4 a0 = acc[ai][bj][m][0], a1 = acc[ai][bj][m][1]; const u32x4 gg = g[m][bj];
                    float r[8] = { bflo(gg.x) * a0[0], bfhi(gg.x) * a0[1], bflo(gg.y) * a0[2], bfhi(gg.y) * a0[3], bflo(gg.z) * a1[0], bfhi(gg.z) * a1[1], bflo(gg.w) * a1[2], bfhi(gg.w) * a1[3] };
                    if (MODE == 1) { const u32x4 tt = t[m][bj];
                        r[0] += bflo(tt.x); r[1] += bfhi(tt.x); r[2] += bflo(tt.y); r[3] += bfhi(tt.y); r[4] += bflo(tt.z); r[5] += bfhi(tt.z); r[6] += bflo(tt.w); r[7] += bfhi(tt.w);
#pragma unroll
                        for (int e = 0; e < 8; ++e) rmx = fmaxf(rmx, fabsf(r[e])); }
                    u32x4 w; w.x = cvt_pk_bf16(r[0], r[1]); w.y = cvt_pk_bf16(r[2], r[3]); w.z = cvt_pk_bf16(r[4], r[5]); w.w = cvt_pk_bf16(r[6], r[7]);
                    *(u32x4*)(rowp + bj * HALF) = w; }
                rm[m] = rmx; }
            if (MODE == 1 && rowmax) {
#pragma unroll
                for (int m = 0; m < 4; ++m) rm[m] = fmaxf(rm[m], __shfl_xor(rm[m], 16));
#pragma unroll
                for (int m = 0; m < 4; ++m) rm[m] = fmaxf(rm[m], __shfl_xor(rm[m], 32));
                if (fq == 0) {
#pragma unroll
                    for (int m = 0; m < 4; ++m) atomicMax(rowmax + (size_t)(row0 + ai * HALF + m * 16), __float_as_uint(rm[m] * 1.00390625f)); } }
            asm volatile("" ::: "memory"); }
    }
};

struct EpiGatedCat {
    static constexpr bool PERM = true, AFTER_DRAIN = false; static constexpr int NSTORE = 16;
    bf16_t* Tm; const bf16_t* gates; unsigned* rowmax;
    __device__ __forceinline__ void mid(f32x4 (&acc)[2][2][4][2], const Unit& u, int wr, int wc, int fr, int fq) const {
        asm volatile("" : "+v"(fr), "+v"(fq));
        const int row0 = u.pm * BM + wr * 64 + fr, col0 = u.pn * BM + wc * 32 + 8 * fq;
#pragma unroll
        for (int ai = 0; ai < 2; ++ai)
#pragma unroll
            for (int mh = 0; mh < 2; ++mh) {
                u32x4 ga[2][2], gb[2][2];
#pragma unroll
                for (int mm = 0; mm < 2; ++mm) { const bf16_t* gp = gates + (size_t)(row0 + ai * HALF + (2 * mh + mm) * 16) * 8192 + col0;
#pragma unroll
                    for (int bj = 0; bj < 2; ++bj) { ga[mm][bj] = __builtin_nontemporal_load((const u32x4*)(gp + bj * HALF)); gb[mm][bj] = *(const u32x4*)(gp + 4096 + bj * HALF); } }
#pragma unroll
                for (int mm = 0; mm < 2; ++mm)
#pragma unroll
                    for (int bj = 0; bj < 2; ++bj) { const u32x4 a = ga[mm][bj], b = gb[mm][bj]; const int m = 2 * mh + mm;
                        acc[ai][bj][m][0][0] *= bflo(a.x) * __builtin_amdgcn_rcpf(fmaxf(bflo(b.x), 1e-30f)); acc[ai][bj][m][0][1] *= bfhi(a.x) * __builtin_amdgcn_rcpf(fmaxf(bfhi(b.x), 1e-30f));
                        acc[ai][bj][m][0][2] *= bflo(a.y) * __builtin_amdgcn_rcpf(fmaxf(bflo(b.y), 1e-30f)); acc[ai][bj][m][0][3] *= bfhi(a.y) * __builtin_amdgcn_rcpf(fmaxf(bfhi(b.y), 1e-30f));
                        acc[ai][bj][m][1][0] *= bflo(a.z) * __builtin_amdgcn_rcpf(fmaxf(bflo(b.z), 1e-30f)); acc[ai][bj][m][1][1] *= bfhi(a.z) * __builtin_amdgcn_rcpf(fmaxf(bfhi(b.z), 1e-30f));
                        acc[ai][bj][m][1][2] *= bflo(a.w) * __builtin_amdgcn_rcpf(fmaxf(bflo(b.w), 1e-30f)); acc[ai][bj][m][1][3] *= bfhi(a.w) * __builtin_amdgcn_rcpf(fmaxf(bfhi(b.w), 1e-30f)); }
                asm volatile("" ::: "memory"); }
    }
    __device__ __forceinline__ void operator()(const f32x4 (&acc)[2][2][4][2], const Unit& u, int wr, int wc, int fr, int fq) const {
        asm volatile("" : "+v"(fr), "+v"(fq));
        const int row0 = u.pm * BM + wr * 64 + fr, col0 = u.pn * BM + wc * 32 + 8 * fq;
#pragma unroll
        for (int ai = 0; ai < 2; ++ai) {
            u32x4 g[4][2];
#pragma unroll
            for (int m = 0; m < 4; ++m) { const bf16_t* gp = gates + (size_t)(row0 + ai * HALF + m * 16) * 8192 + 4096 + col0;
#pragma unroll
                for (int bj = 0; bj < 2; ++bj) g[m][bj] = __builtin_nontemporal_load((const u32x4*)(gp + bj * HALF)); }
            float rm[4];
#pragma unroll
            for (int m = 0; m < 4; ++m) { bf16_t* rowp = Tm + (size_t)(row0 + ai * HALF + m * 16) * 4096 + col0; float rmx = 0.f;
#pragma unroll
                for (int bj = 0; bj < 2; ++bj) { const f32x4 a0 = acc[ai][bj][m][0], a1 = acc[ai][bj][m][1]; const u32x4 gg = g[m][bj];
                    const float bn[8] = { bflo(gg.x), bfhi(gg.x), bflo(gg.y), bfhi(gg.y), bflo(gg.z), bfhi(gg.z), bflo(gg.w), bfhi(gg.w) };
                    float r[8];
#pragma unroll
                    for (int e = 0; e < 4; ++e) { r[e] = fmaxf(bn[e], 1e-30f) * a0[e]; r[4 + e] = fmaxf(bn[4 + e], 1e-30f) * a1[e]; }
#pragma unroll
                    for (int e = 0; e < 8; ++e) rmx = fmaxf(rmx, fabsf(r[e]));
                    u32x4 w; w.x = cvt_pk_bf16(r[0], r[1]); w.y = cvt_pk_bf16(r[2], r[3]); w.z = cvt_pk_bf16(r[4], r[5]); w.w = cvt_pk_bf16(r[6], r[7]);
                    *(u32x4*)(rowp + bj * HALF) = w; }
                rm[m] = rmx; }
            if (rowmax) {
#pragma unroll
                for (int m = 0; m < 4; ++m) rm[m] = fmaxf(rm[m], __shfl_xor(rm[m], 16));
#pragma unroll
                for (int m = 0; m < 4; ++m) rm[m] = fmaxf(rm[m], __shfl_xor(rm[m], 32));
                if (fq == 0) {
#pragma unroll
                    for (int m = 0; m < 4; ++m) atomicMax(rowmax + (size_t)(row0 + ai * HALF + m * 16), __float_as_uint(rm[m] * 1.00390625f)); } }
            asm volatile("" ::: "memory"); }
    }
};

template <bool I8, int MODE> struct EpiResidP {
    static constexpr bool PERM = true, AFTER_DRAIN = false; static constexpr int NSTORE = MODE == 0 ? 16 : 32;
    const void* base; void* out; const float* gvec; const float* sA; const float* sB;
    template <class ACC> __device__ __forceinline__ void operator()(const ACC (&acc)[2][2][4][2], const Unit& u, int wr, int wc, int fr, int fq) const {
        const int row0 = u.pm * BM + wr * 64 + fr, col0 = u.pn * BM + wc * 32 + 8 * fq;
        const float* gv = gvec + (size_t)(u.pm >> 4) * 24576 + col0;
        f32x4 g0[2], g1[2], s0[2], s1[2];
#pragma unroll
        for (int bj = 0; bj < 2; ++bj) { g0[bj] = *(const f32x4*)(gv + bj * HALF); g1[bj] = *(const f32x4*)(gv + bj * HALF + 4);
            if (I8) { s0[bj] = *(const f32x4*)(sB + col0 + bj * HALF); s1[bj] = *(const f32x4*)(sB + col0 + bj * HALF + 4); } }
        asm volatile("" : "+v"(g0[0]), "+v"(g1[0]), "+v"(g0[1]), "+v"(g1[1]));
        if (I8) { asm volatile("" : "+v"(s0[0]), "+v"(s1[0]), "+v"(s0[1]), "+v"(s1[1]));
#pragma unroll
            for (int bj = 0; bj < 2; ++bj) { g0[bj] = g0[bj] * s0[bj]; g1[bj] = g1[bj] * s1[bj]; } }
#pragma unroll
        for (int ai = 0; ai < 2; ++ai) {
            f32x4 b0[4][2], b1[4][2]; u32x4 bb[4][2]; float sa[4];
#pragma unroll
            for (int m = 0; m < 4; ++m) { const int row = row0 + ai * HALF + m * 16; const size_t off = (size_t)row * 4096 + col0; sa[m] = I8 ? sA[row] : 1.f;
#pragma unroll
                for (int bj = 0; bj < 2; ++bj) {
                    if (MODE == 0) { b0[m][bj] = __builtin_nontemporal_load((const f32x4*)((const float*)base + off + bj * HALF)); b1[m][bj] = __builtin_nontemporal_load((const f32x4*)((const float*)base + off + bj * HALF + 4)); }
                    else bb[m][bj] = __builtin_nontemporal_load((const u32x4*)((const bf16_t*)base + off + bj * HALF)); } }
#pragma unroll
            for (int m = 0; m < 4; ++m) { const int row = row0 + ai * HALF + m * 16; const size_t off = (size_t)row * 4096 + col0;
#pragma unroll
                for (int bj = 0; bj < 2; ++bj) { f32x4 v0, v1;
#pragma unroll
                    for (int e = 0; e < 4; ++e) { v0[e] = (float)acc[ai][bj][m][0][e]; v1[e] = (float)acc[ai][bj][m][1][e]; }
                    if (I8) { v0 = v0 * sa[m]; v1 = v1 * sa[m]; }
                    if (MODE == 0) { const f32x4 r0 = b0[m][bj] + g0[bj] * v0, r1 = b1[m][bj] + g1[bj] * v1;
                        u32x4 w; w.x = cvt_pk_bf16(r0[0], r0[1]); w.y = cvt_pk_bf16(r0[2], r0[3]); w.z = cvt_pk_bf16(r1[0], r1[1]); w.w = cvt_pk_bf16(r1[2], r1[3]);
                        *(u32x4*)((bf16_t*)out + off + bj * HALF) = w; }
                    else { const u32x4 t = bb[m][bj];
                        const f32x4 x0 = (f32x4){bflo(t.x), bfhi(t.x), bflo(t.y), bfhi(t.y)}, x1 = (f32x4){bflo(t.z), bfhi(t.z), bflo(t.w), bfhi(t.w)};
                        *(f32x4*)((float*)out + off + bj * HALF) = x0 + g0[bj] * v0; *(f32x4*)((float*)out + off + bj * HALF + 4) = x1 + g1[bj] * v1; } } }
            asm volatile("" ::: "memory"); }
    }
};

template <bool I8> struct EpiResid {
    static constexpr bool PERM = false, AFTER_DRAIN = false; static constexpr int NSTORE = 32;
    const float* base; float* out; const float* gvec; const float* sA; const float* sB;
    template <class ACC> __device__ __forceinline__ void operator()(const ACC (&acc)[2][2][4][2], const Unit& u, int wr, int wc, int fr, int fq) const {
        const int row0 = u.pm * BM + wr * 64 + fr, col0 = u.pn * BM + wc * 32 + 4 * fq;
        const float* gv = gvec + (size_t)(u.pm >> 4) * 24576 + col0;
        f32x4 gm[2][2], sb[2][2];
#pragma unroll
        for (int bj = 0; bj < 2; ++bj)
#pragma unroll
            for (int n = 0; n < 2; ++n) { gm[bj][n] = *(const f32x4*)(gv + bj * HALF + n * 16); if (I8) sb[bj][n] = *(const f32x4*)(sB + col0 + bj * HALF + n * 16); }
        asm volatile("" : "+v"(gm[0][0]), "+v"(gm[0][1]), "+v"(gm[1][0]), "+v"(gm[1][1]));
        if (I8) { asm volatile("" : "+v"(sb[0][0]), "+v"(sb[0][1]), "+v"(sb[1][0]), "+v"(sb[1][1]));
#pragma unroll
            for (int bj = 0; bj < 2; ++bj)
#pragma unroll
                for (int n = 0; n < 2; ++n) gm[bj][n] = gm[bj][n] * sb[bj][n]; }
#pragma unroll
        for (int ai = 0; ai < 2; ++ai) {
            f32x4 bs[4][2][2]; float sa[4];
#pragma unroll
            for (int m = 0; m < 4; ++m) { const int row = row0 + ai * HALF + m * 16; const size_t off = (size_t)row * 4096 + col0; sa[m] = I8 ? sA[row] : 1.f;
#pragma unroll
                for (int bj = 0; bj < 2; ++bj)
#pragma unroll
                    for (int n = 0; n < 2; ++n) bs[m][bj][n] = __builtin_nontemporal_load((const f32x4*)(base + off + bj * HALF + n * 16)); }
#pragma unroll
            for (int m = 0; m < 4; ++m) { const int row = row0 + ai * HALF + m * 16; const size_t off = (size_t)row * 4096 + col0;
#pragma unroll
                for (int bj = 0; bj < 2; ++bj)
#pragma unroll
                    for (int n = 0; n < 2; ++n) { f32x4 av;
#pragma unroll
                        for (int e = 0; e < 4; ++e) av[e] = (float)acc[ai][bj][m][n][e];
                        if (I8) av = av * sa[m];
                        *(f32x4*)(out + off + bj * HALF + n * 16) = bs[m][bj][n] + gm[bj][n] * av; } }
            asm volatile("" ::: "memory"); }
    }
};
template <class Epi, class Sched, bool ALIGN_EPI = false, bool SP2 = false, class AMap = AMapNat, class MMA = MmaBf16, int KMID = 0>
__device__ __forceinline__ void gemm_phase(PG8_LAS unsigned char* lds, const Gemm g, const Sched& S, const Epi& E) {
    const int tid = threadIdx.x, wid = __builtin_amdgcn_readfirstlane(tid >> 6), lane = tid & 63, wr = wid >> 2, wc = wid & 3, fr = lane & 15, fq = lane >> 4;
    const int K = g.K, nt = K / BK;
    int voffA[2]; unsigned voffB[2];
#pragma unroll
    for (int i = 0; i < 2; ++i) { int R, C; stage_rc(tid * 16 + i * 8192, R, C); const int Rb = Epi::PERM ? ((R & ~31) + perm32(R & 31)) : R;
        voffA[i] = AMap::voff(R, C, K); voffB[i] = (unsigned)(Rb * K + C) * 2u; }
    const size_t kstep = (size_t)(BK * 2);
    const size_t hstepB = (size_t)HALF * K * 2, tstepB = 2 * hstepB;
    const size_t hstepA = AMap::hstep(K), tstepA = AMap::tstep(K);
    const unsigned ldsw = (unsigned)wid * 1024u;
    const int aoff = lds_byte(wr * 64 + fr, fq * 8), boff = lds_byte(wc * 32 + fr, fq * 8);
#define PG8_SA(b, h) (((b) * 2 + (h)) * HTB)
#define PG8_SB(b, h) ((4 + (b) * 2 + (h)) * HTB)
#define PG8_STAGE(bufoff, gbase, voff) do { _Pragma("unroll") for (int _i = 0; _i < 2; ++_i) \
        __builtin_amdgcn_global_load_lds((const unsigned*)((const char*)(gbase) + (voff)[_i]), (PG8_LAS unsigned*)(lds + (bufoff) + ldsw + _i * 8192), 16, 0, 0); } while (0)
#define PG8_LDA(dst, b, h) do { _Pragma("unroll") for (int m = 0; m < 4; ++m) _Pragma("unroll") for (int k = 0; k < 2; ++k) dst[m][k] = *(const PG8_LAS bf16x8*)(lds + PG8_SA(b, h) + aoff + m * 2048 + k * 1024); } while (0)
#define PG8_LDB(dst, b, h) do { _Pragma("unroll") for (int n = 0; n < 2; ++n) _Pragma("unroll") for (int k = 0; k < 2; ++k) dst[n][k] = *(const PG8_LAS bf16x8*)(lds + PG8_SB(b, h) + boff + n * 2048 + k * 1024); } while (0)
#define PG8_MMA(ai, bj, At, Bt) do { __builtin_amdgcn_s_setprio(1); _Pragma("unroll") for (int m = 0; m < 4; ++m) _Pragma("unroll") for (int n = 0; n < 2; ++n) _Pragma("unroll") for (int k = 0; k < 2; ++k) \
        acc[ai][bj][m][n] = MMA::mma(Bt[n][k], At[m][k], acc[ai][bj][m][n]); __builtin_amdgcn_s_setprio(0); } while (0)
#define PG8_WAIT_V(n) asm volatile("s_waitcnt vmcnt(" #n ")" ::: "memory")
#define PG8_WAIT_L(n) asm volatile("s_waitcnt lgkmcnt(" #n ")" ::: "memory")
#define PG8_WAIT_V8R(rl) asm volatile("s_cmp_eq_u32 %0, 0\n\ts_cbranch_scc1 1f\n\ts_waitcnt vmcnt(%1)\n\ts_branch 2f\n1:\n\ts_waitcnt vmcnt(8)\n2:" :: "s"(rl), "n"(8 + Epi::NSTORE) : "memory", "scc")
#define PG8_BAR __builtin_amdgcn_s_barrier()
#define PG8_SCHED __builtin_amdgcn_sched_barrier(0)
    Unit cur, nxt; int ui = 0; bool rlx = false;
    if (!S.next(0, cur)) return;
    typename MMA::acc_t acc[2][2][4][2];
#pragma unroll
    for (int a = 0; a < 2; ++a)
#pragma unroll
        for (int b = 0; b < 2; ++b)
#pragma unroll
            for (int m = 0; m < 4; ++m)
#pragma unroll
                for (int n = 0; n < 2; ++n) acc[a][b][m][n] = MMA::zero();
    bf16x8 At[4][2], B0[2][2], B1[2][2];
    const char* cA = (const char*)g.A + (size_t)cur.pm * tstepA; const char* cB = (const char*)g.Bt + (size_t)cur.pn * tstepB;
    S.a_ready(cur);
    if constexpr (SP2) {
        PG8_STAGE(PG8_SB(0, 0), cB, voffB); PG8_STAGE(PG8_SB(0, 1), cB + hstepB, voffB); PG8_STAGE(PG8_SA(0, 0), cA, voffA); PG8_STAGE(PG8_SA(0, 1), cA + hstepA, voffA);
        if (wr == 1) PG8_BAR;
        PG8_WAIT_V(2); PG8_BAR;
        PG8_STAGE(PG8_SB(1, 0), cB + kstep, voffB); PG8_STAGE(PG8_SA(1, 0), cA + kstep, voffA); PG8_STAGE(PG8_SB(1, 1), cB + hstepB + kstep, voffB);
        PG8_WAIT_V(6); PG8_BAR;
    } else {
        PG8_STAGE(PG8_SB(0, 0), cB, voffB); PG8_STAGE(PG8_SA(0, 0), cA, voffA); PG8_STAGE(PG8_SB(0, 1), cB + hstepB, voffB); PG8_STAGE(PG8_SA(0, 1), cA + hstepA, voffA);
        if (wr == 1) PG8_BAR;
        PG8_WAIT_V(4); PG8_BAR;
        PG8_STAGE(PG8_SB(1, 0), cB + kstep, voffB); PG8_STAGE(PG8_SA(1, 0), cA + kstep, voffA); PG8_STAGE(PG8_SB(1, 1), cB + hstepB + kstep, voffB);
        PG8_WAIT_V(6); PG8_BAR;
    }
    for (;;) {
        const bool has_next = S.next(ui + 1, nxt);
        const char* nA = has_next ? (const char*)g.A + (size_t)nxt.pm * tstepA : cA; const char* nB = has_next ? (const char*)g.Bt + (size_t)nxt.pn * tstepB : cB;
        _Pragma("unroll") for (int seg = 0; seg < (KMID ? 2 : 1); ++seg) {
        const int tA = seg ? KMID : 0, tB = (KMID && seg == 0) ? KMID : nt;
        for (int t = tA; t < tB; t += 2) {
            const bool last = (t == nt - 2);
            const char* a1 = cA + (size_t)(t + 1) * kstep;
            const char* a2 = last ? nA : cA + (size_t)(t + 2) * kstep; const char* b2 = last ? nB : cB + (size_t)(t + 2) * kstep;
            const char* a3 = a2 + kstep; const char* b3 = b2 + kstep;
            if (last && has_next) S.a_ready(nxt);
            if constexpr (SP2) {
            const int rl = __builtin_amdgcn_readfirstlane((rlx && t == 0) ? 1 : 0);
            PG8_LDB(B0, 0, 0); PG8_LDB(B1, 0, 1); PG8_SCHED; PG8_LDA(At, 0, 0); PG8_STAGE(PG8_SA(1, 1), a1 + hstepA, voffA);
            PG8_WAIT_V8R(rl); PG8_WAIT_L(0); PG8_BAR; PG8_MMA(0, 0, At, B0); PG8_MMA(0, 1, At, B1); PG8_BAR; PG8_SCHED;
            PG8_LDA(At, 0, 1); PG8_STAGE(PG8_SB(0, 0), b2, voffB); PG8_STAGE(PG8_SB(0, 1), b2 + hstepB, voffB); PG8_STAGE(PG8_SA(0, 0), a2, voffA);
            PG8_WAIT_V8R(rl); PG8_WAIT_L(0); PG8_BAR; PG8_MMA(1, 0, At, B0); PG8_MMA(1, 1, At, B1); PG8_BAR; PG8_SCHED;
            PG8_LDB(B0, 1, 0); PG8_LDB(B1, 1, 1); PG8_SCHED; PG8_LDA(At, 1, 0); PG8_STAGE(PG8_SA(0, 1), a2 + hstepA, voffA);
            PG8_WAIT_V(8); PG8_WAIT_L(0); PG8_BAR; PG8_MMA(0, 0, At, B0); PG8_MMA(0, 1, At, B1); PG8_BAR; PG8_SCHED;
            PG8_LDA(At, 1, 1); PG8_STAGE(PG8_SB(1, 0), b3, voffB); PG8_STAGE(PG8_SB(1, 1), b3 + hstepB, voffB); PG8_STAGE(PG8_SA(1, 0), a3, voffA);
            PG8_WAIT_V(8); PG8_WAIT_L(0); PG8_BAR; PG8_MMA(1, 0, At, B0); PG8_MMA(1, 1, At, B1); PG8_BAR; PG8_SCHED;
            } else {
            PG8_LDB(B0, 0, 0); PG8_SCHED; PG8_LDA(At, 0, 0); PG8_STAGE(PG8_SA(1, 1), a1 + hstepA, voffA);
            PG8_WAIT_L(8); PG8_BAR; PG8_WAIT_L(0); PG8_MMA(0, 0, At, B0); PG8_BAR; PG8_SCHED;
            PG8_LDB(B1, 0, 1); PG8_STAGE(PG8_SB(0, 0), b2, voffB);
            PG8_BAR; PG8_WAIT_L(0); PG8_MMA(0, 1, At, B1); PG8_BAR;
            PG8_LDA(At, 0, 1); PG8_STAGE(PG8_SA(0, 0), a2, voffA);
            PG8_BAR; PG8_WAIT_L(0); PG8_MMA(1, 0, At, B0); PG8_BAR; PG8_SCHED;
            PG8_STAGE(PG8_SB(0, 1), b2 + hstepB, voffB);
            PG8_WAIT_V(6); PG8_BAR; PG8_MMA(1, 1, At, B1); PG8_BAR;
            PG8_LDB(B0, 1, 0); PG8_SCHED; PG8_LDA(At, 1, 0); PG8_STAGE(PG8_SA(0, 1), a2 + hstepA, voffA);
            PG8_WAIT_L(8); PG8_BAR; PG8_WAIT_L(0); PG8_MMA(0, 0, At, B0); PG8_BAR; PG8_SCHED;
            PG8_LDB(B1, 1, 1); PG8_STAGE(PG8_SB(1, 0), b3, voffB);
            PG8_BAR; PG8_WAIT_L(0); PG8_MMA(0, 1, At, B1); PG8_BAR;
            PG8_LDA(At, 1, 1); PG8_STAGE(PG8_SA(1, 0), a3, voffA);
            PG8_BAR; PG8_WAIT_L(0); PG8_MMA(1, 0, At, B0); PG8_BAR; PG8_SCHED;
            PG8_STAGE(PG8_SB(1, 1), b3 + hstepB, voffB);
            PG8_WAIT_V(6); PG8_BAR; PG8_MMA(1, 1, At, B1); PG8_BAR;
            }
        }
        if constexpr (KMID != 0) { if (seg == 0) E.mid(acc, cur, wr, wc, fr, fq); }
        }
        if constexpr (ALIGN_EPI) { if (wr == 0) PG8_BAR; }
        if constexpr (!Epi::AFTER_DRAIN) { E(acc, cur, wr, wc, fr, fq); S.done(cur); rlx = (Epi::NSTORE > 0); }
        if (!has_next) break;
#pragma unroll
        for (int a = 0; a < 2; ++a)
#pragma unroll
            for (int b = 0; b < 2; ++b)
#pragma unroll
                for (int m = 0; m < 4; ++m)
#pragma unroll
                    for (int n = 0; n < 2; ++n) acc[a][b][m][n] = MMA::zero();
        cur = nxt; cA = nA; cB = nB; ++ui;
        if constexpr (ALIGN_EPI) { if (wr == 1) PG8_BAR; }
    }
    PG8_WAIT_V(0);
    if constexpr (!ALIGN_EPI) { if (wr == 0) PG8_BAR; }
    PG8_BAR;
    if constexpr (Epi::AFTER_DRAIN) { E.fused(acc, cur, wr, wc, fr, fq, lds, wid, lane); S.done(cur); }
#undef PG8_SA
#undef PG8_SB
#undef PG8_STAGE
#undef PG8_LDA
#undef PG8_LDB
#undef PG8_MMA
#undef PG8_WAIT_V
#undef PG8_WAIT_L
#undef PG8_WAIT_V8R
#undef PG8_BAR
#undef PG8_SCHED
}
}

#define LAS __attribute__((address_space(3)))
typedef unsigned short bf16;
typedef short bf16x8 __attribute__((ext_vector_type(8)));
typedef float f32x4 __attribute__((ext_vector_type(4)));
typedef unsigned u32x4 __attribute__((ext_vector_type(4)));
typedef unsigned u32x2 __attribute__((ext_vector_type(2)));

constexpr int NWAVES = 8, NTHR = 512;
constexpr int D = 4096, NBATCH = 4, T = 4096, M = NBATCH * T;
constexpr int N_IN = 25632, N_IN_PAD = 25856, DFF = 11008, NMOD = 6 * D;
constexpr float EPS = 1e-6f;
constexpr int N_PHASES = 13;

constexpr size_t MiB = 1u << 20;
#ifndef I8_PROJ
#define I8_PROJ 1
#endif
#ifndef I8_O
#define I8_O 1
#endif
#ifndef CATAB
#define CATAB 1
#endif
#ifndef X1B
#define X1B 1
#endif
#ifndef I8_UP
#define I8_UP 0
#endif
constexpr size_t WS_CTL = 0, CTL_ZERO_BYTES = 352256, WS_CM_IN = 65536, WS_CM_UP = 65536 + 106496, WS_CM_O = 262144, WS_RM_O = 262144 + 16384;
constexpr size_t WS_MOD = 1 * MiB, WS_DEC = 1 * MiB + 512 * 1024, WS_SMALL = 1 * MiB + 768 * 1024;
constexpr size_t WS_BT_A = 2 * MiB, WS_BT_B = 18 * MiB, WS_BT_O = 26 * MiB, WS_BT_UP = 58 * MiB, WS_BT_DN = 230 * MiB;
constexpr size_t WS_RA = 316 * MiB;
constexpr size_t WS_BT_IN = WS_RA, WS_H = WS_RA + 202 * MiB;
constexpr size_t WS_D1 = WS_RA;
constexpr size_t WS_TM = WS_RA;
constexpr size_t WS_H2 = WS_RA;
constexpr size_t WS_RB = 662 * MiB;
constexpr size_t WS_QKVA = WS_RB, WS_Z = WS_RB + 192 * MiB, WS_QKVB = WS_RB + 256 * MiB, WS_GATES = WS_RB + 544 * MiB, WS_BG = WS_RB + 800 * MiB;
constexpr size_t WS_ACT = WS_RB;
constexpr size_t WS_OAN = WS_RB, WS_OB = WS_RB + 64 * MiB;
constexpr size_t WS_RC = 1464 * MiB;
constexpr size_t WS_SWAO = WS_RC, WS_LSE = WS_RC + 96 * MiB, WS_OA = WS_RC + 98 * MiB;
constexpr size_t WS_X1B = WS_RC;
constexpr size_t WS_ROPE = 1626 * MiB;
constexpr size_t WS_SA_IN = 1628 * MiB, WS_SB_IN = WS_SA_IN + 65536, WS_SA_UP = WS_SB_IN + 106496, WS_SB_UP = WS_SA_UP + 65536;
constexpr size_t WS_SA_O = WS_SB_UP + 90112, WS_SB_O = WS_SA_O + 65536;
constexpr size_t WS_TMQ = WS_RA + 128 * MiB;
constexpr size_t WS_END = 1629 * MiB;
constexpr size_t D1_CHUNK_BYTES = 73728;
constexpr int CW_BAR = 1024;

constexpr int LDS_BYTES = 147456;
constexpr int XL_OFF = 131072;
constexpr int MISC_OFF = 147456 - 256;

#define LDS_WAIT() asm volatile("s_waitcnt lgkmcnt(0)" ::: "memory")
#define VM_WAIT() asm volatile("s_waitcnt vmcnt(0)" ::: "memory")
typedef __bf16 bf16x2_t __attribute__((ext_vector_type(2)));
typedef float f32x2_t __attribute__((ext_vector_type(2)));
__device__ __forceinline__ unsigned pk2(float lo, float hi) { const f32x2_t v = {lo, hi}; const bf16x2_t b = __builtin_convertvector(v, bf16x2_t); return __builtin_bit_cast(unsigned, b); }
__device__ __forceinline__ unsigned f2bf(float f) { return pk2(f, f) & 0xffffu; }
__device__ __forceinline__ float bflo(unsigned w) { return __uint_as_float(w << 16); }
__device__ __forceinline__ float bfhi(unsigned w) { return __uint_as_float(w & 0xffff0000u); }
__device__ __forceinline__ float fexp(float x) { return __builtin_amdgcn_exp2f(x * 1.4426950408889634f); }
__device__ __forceinline__ float silu_(float x) { return x * __builtin_amdgcn_rcpf(1.0f + fexp(-x)); }
__device__ __forceinline__ float wave_sum(float v) {
#pragma unroll
    for (int o = 1; o < 64; o <<= 1) v += __shfl_xor(v, o);
    return v;
}
__device__ __forceinline__ void unpack8(const u32x4 r, float (&f)[8]) { f[0] = bflo(r.x); f[1] = bfhi(r.x); f[2] = bflo(r.y); f[3] = bfhi(r.y); f[4] = bflo(r.z); f[5] = bfhi(r.z); f[6] = bflo(r.w); f[7] = bfhi(r.w); }
__device__ __forceinline__ u32x4 pack8(const float (&f)[8]) { u32x4 w; w.x = pk2(f[0], f[1]); w.y = pk2(f[2], f[3]); w.z = pk2(f[4], f[5]); w.w = pk2(f[6], f[7]); return w; }
__device__ __forceinline__ bf16x8 ldfrag(const LAS unsigned char* base, int stride, int row0, int k0, int lane) {
    return *(const LAS bf16x8*)(base + (row0 + (lane & 15)) * stride + (k0 + 8 * (lane >> 4)) * 2);
}
#define MFMA16(a, b, c) __builtin_amdgcn_mfma_f32_16x16x32_bf16((a), (b), (c), 0, 0, 0)

#define XB_TMO      128
#define XB_XCNT(j)  (256  + 64 * (j))
#define XB_XSUB(j)  (1280 + 64 * (j))
#define XB_XGEN(j)  (2304 + 64 * (j))
#define XB_TOP      3328
#define XB_TOPGEN   3392
#define XCD_BAR_WORDS 3456
#define XB_SPIN_CAP (1u << 18)
__device__ __forceinline__ unsigned xb_ld(unsigned* p)              { return __hip_atomic_load(p, __ATOMIC_RELAXED, __HIP_MEMORY_SCOPE_AGENT); }
__device__ __forceinline__ unsigned xb_add(unsigned* p, unsigned v) { return __hip_atomic_fetch_add(p, v, __ATOMIC_RELAXED, __HIP_MEMORY_SCOPE_AGENT); }
__device__ __forceinline__ unsigned xb_xcc_id() { return (unsigned)__builtin_amdgcn_s_getreg((3 << 11) | 20) & 0xFu; }
#define XB_SPIN(cond, bar) do { unsigned _sp = 0; while (cond) { __builtin_amdgcn_s_sleep(1); \
    if ((++_sp & 255u) == 0u) { if (xb_ld(&(bar)[XB_TMO])) break; if (_sp > XB_SPIN_CAP) { atomicAdd(&(bar)[XB_TMO], 1u); break; } } } } while (0)
struct XcdBarrier { unsigned* bar; unsigned x; volatile LAS unsigned* st; };
__device__ __forceinline__ XcdBarrier xcd_barrier_post(unsigned* bar, volatile LAS unsigned* st) {
    XcdBarrier b; b.bar = bar; b.x = xb_xcc_id(); b.st = st;
    if (threadIdx.x == 0) (void)xb_add(&bar[XB_XCNT(b.x)], 1u);
    return b;
}
__device__ __forceinline__ void xcd_barrier_complete(unsigned* bar, unsigned x, unsigned& nloc, unsigned& nx) {
    const unsigned G = gridDim.x * gridDim.y * gridDim.z;
    unsigned sum, cnt, mine, sp = 0u;
    for (;;) {
        sum = 0u; cnt = 0u; mine = 0u;
#pragma unroll
        for (unsigned j = 0; j < 16; ++j) { const unsigned c = xb_ld(&bar[XB_XCNT(j)]); sum += c; cnt += (c > 0u) ? 1u : 0u; mine = (j == x) ? c : mine; }
        if (sum == G) break;
        __builtin_amdgcn_s_sleep(1);
        if ((++sp & 255u) == 0u) { if (xb_ld(&bar[XB_TMO])) break; if (sp > XB_SPIN_CAP) { atomicAdd(&bar[XB_TMO], 1u); break; } }
    }
    nloc = mine > 0u ? mine : 1u; nx = cnt > 0u ? cnt : 1u;
}
__device__ __forceinline__ void xcd_barrier(const XcdBarrier& b) {
    asm volatile("s_waitcnt vmcnt(0)" ::: "memory");
    __syncthreads();
    if (threadIdx.x == 0) {
        unsigned* bar = b.bar;
        __builtin_amdgcn_s_waitcnt(0);
        unsigned nloc = b.st[0], nx = b.st[1];
        if (nloc == 0u) { xcd_barrier_complete(bar, b.x, nloc, nx); b.st[0] = nloc; b.st[1] = nx; }
        const unsigned old = xb_add(&bar[XB_XSUB(b.x)], 1u);
        const unsigned gen = old / nloc;
        if (old + 1u == (gen + 1u) * nloc) {
            __builtin_amdgcn_fence(__ATOMIC_RELEASE, "agent");
            asm volatile("s_waitcnt vmcnt(0)" ::: "memory");
            const unsigned og = xb_add(&bar[XB_TOP], 1u);
            const unsigned tg = og / nx;
            if (og + 1u == (tg + 1u) * nx) xb_add(&bar[XB_TOPGEN], 1u);
            else XB_SPIN(xb_ld(&bar[XB_TOPGEN]) == tg, bar);
            __builtin_amdgcn_fence(__ATOMIC_ACQUIRE, "agent");
            xb_add(&bar[XB_XGEN(b.x)], 1u);
            asm volatile("s_waitcnt vmcnt(0)" ::: "memory");
        } else {
            XB_SPIN(xb_ld(&bar[XB_XGEN(b.x)]) == gen, bar);
            __builtin_amdgcn_fence(__ATOMIC_ACQUIRE, "agent");
            asm volatile("s_waitcnt vmcnt(0)" ::: "memory");
        }
    }
    __syncthreads();
}

struct Frame {
    LAS unsigned char* lds;
    int tid, lane, wave, vcu, G;
    float* out;
    unsigned char* ws;
};
enum { I_X = 0, I_C, I_POS, I_WADA, I_BADA, I_WIN, I_BGATE, I_CONVQKV, I_ALOG, I_DTBIAS, I_OGAIN, I_WA, I_QGAIN, I_KGAIN, I_WB, I_WO, I_WUP, I_CONVFFN, I_WDOWN };
template <int IDX> __device__ __forceinline__ const float* karg() {
    unsigned long long p; asm volatile("s_load_dwordx2 %0, %1, %2\n\ts_waitcnt lgkmcnt(0)" : "=s"(p) : "s"(__builtin_amdgcn_kernarg_segment_ptr()), "i"(8 * IDX) : "memory");
    const float* q = (const float*)(const __attribute__((address_space(1))) float*)p;
    return q;
}
#define WSP(T_, off) ((T_*)(F.ws + (off)))

__device__ __forceinline__ unsigned q8x4(float a, float b, float c, float d, float s) {
    const int q0 = (int)__builtin_rintf(a * s), q1 = (int)__builtin_rintf(b * s), q2 = (int)__builtin_rintf(c * s), q3 = (int)__builtin_rintf(d * s);
    return (unsigned)(q0 & 255) | ((unsigned)(q1 & 255) << 8) | ((unsigned)(q2 & 255) << 16) | ((unsigned)q3 << 24);
}
template <int OUT, bool UPIL, bool NTST = false> __device__ __forceinline__ void transpose_item(const float* __restrict__ W, int ldw, int src_col0, int nblk, void* WTv, int K, int dst_row0, LAS float* scr, int item, int lane, unsigned* colmax = nullptr, float* sB = nullptr) {
    const int kb = item / nblk, nb = item - kb * nblk, k0 = 64 * kb, n0 = 32 * nb;
    { const int r8 = lane >> 3, c4 = lane & 7;
      const float* src = W + (size_t)(k0 + r8) * ldw + src_col0 + n0 + 4 * c4;
      f32x4 t[8];
#pragma unroll
      for (int i = 0; i < 8; ++i) t[i] = __builtin_nontemporal_load((const f32x4*)(src + (size_t)(8 * i) * ldw));
#pragma unroll
      for (int i = 0; i < 8; ++i) { LAS float* d = scr + (8 * i + r8) * 33 + 4 * c4; d[0] = t[i].x; d[1] = t[i].y; d[2] = t[i].z; d[3] = t[i].w; } }
    LDS_WAIT();
    int drow0 = dst_row0 + n0;
    if (UPIL) { const int isv = n0 >= DFF, n1 = isv ? n0 - DFF : n0; drow0 = 256 * (n1 >> 7) + 128 * isv + (n1 & 127); }
    if (OUT == 1) {
        float m = 0.f; const LAS float* sp = scr + (32 * (lane >> 5)) * 33 + (lane & 31);
#pragma unroll
        for (int kk = 0; kk < 32; ++kk) m = fmaxf(m, fabsf(sp[kk * 33]));
        m = fmaxf(m, __shfl_xor(m, 32));
        if (lane < 32) atomicMax(colmax + drow0 + lane, __float_as_uint(m));
    } else if (OUT == 2) {
        const int n = lane >> 1, half = lane & 1, row = drow0 + n;
        const float cm = __uint_as_float(colmax[row]), inv = cm > 0.f ? 127.0f / cm : 0.f;
        if (kb == 0 && half == 0) sB[row] = cm * (1.0f / 127.0f);
        const LAS float* sp = scr + (32 * half) * 33 + n;
        u32x4 w0, w1;
        w0.x = q8x4(sp[0 * 33], sp[1 * 33], sp[2 * 33], sp[3 * 33], inv); w0.y = q8x4(sp[4 * 33], sp[5 * 33], sp[6 * 33], sp[7 * 33], inv); w0.z = q8x4(sp[8 * 33], sp[9 * 33], sp[10 * 33], sp[11 * 33], inv); w0.w = q8x4(sp[12 * 33], sp[13 * 33], sp[14 * 33], sp[15 * 33], inv);
        w1.x = q8x4(sp[16 * 33], sp[17 * 33], sp[18 * 33], sp[19 * 33], inv); w1.y = q8x4(sp[20 * 33], sp[21 * 33], sp[22 * 33], sp[23 * 33], inv); w1.z = q8x4(sp[24 * 33], sp[25 * 33], sp[26 * 33], sp[27 * 33], inv); w1.w = q8x4(sp[28 * 33], sp[29 * 33], sp[30 * 33], sp[31 * 33], inv);
        u32x4* dst = (u32x4*)((unsigned char*)WTv + (size_t)row * K + k0 + 32 * half);
        dst[0] = w0; dst[1] = w1;
    } else {
        bf16* WT = (bf16*)WTv; const int c = lane & 7;
#pragma unroll
        for (int j = 0; j < 4; ++j) { const int n = (lane >> 3) + 8 * j; const LAS float* s = scr + (8 * c) * 33 + n;
            u32x4 o; o.x = pk2(s[0 * 33], s[1 * 33]); o.y = pk2(s[2 * 33], s[3 * 33]); o.z = pk2(s[4 * 33], s[5 * 33]); o.w = pk2(s[6 * 33], s[7 * 33]);
            if (NTST) __builtin_nontemporal_store(o, (u32x4*)(WT + (size_t)(drow0 + n) * K + k0 + 8 * c)); else *(u32x4*)(WT + (size_t)(drow0 + n) * K + k0 + 8 * c) = o; }
    }
    LDS_WAIT();
}
constexpr int I_IN1 = 64 * 256, I_IN2 = 64 * 1, I_IN3 = 64 * 544, I_UP = 64 * 688, I_O = 64 * 128;
__device__ __forceinline__ void phase_quant_weights(Frame& F) {
    const int lane = F.lane, gw = F.vcu * NWAVES + F.wave, NGW = F.G * NWAVES;
    LAS float* scr = (LAS float*)(F.lds + F.wave * 8448);
    constexpr int NQ = (I8_PROJ ? I_IN1 + I_IN2 + I_IN3 : 0) + (I8_O ? I_O : 0) + (I8_UP ? I_UP : 0);
    if (NQ == 0) return;
    const float* Fw_in = karg<I_WIN>(); const float* Fw_up = karg<I_WUP>();
    unsigned* cm_in = (unsigned*)(F.ws + WS_CM_IN); unsigned* cm_up = (unsigned*)(F.ws + WS_CM_UP);
    for (int it = gw; it < NQ; it += NGW) {
        int r = it;
        if (I8_PROJ) {
            if (r < I_IN1) { transpose_item<2, false>(Fw_in, N_IN, 0, 256, F.ws + WS_BT_IN, D, 0, scr, r, lane, cm_in, WSP(float, WS_SB_IN)); continue; } r -= I_IN1;
            if (r < I_IN2) { transpose_item<2, false>(Fw_in, N_IN, 8192, 1, F.ws + WS_BT_IN, D, 25600, scr, r, lane, cm_in, WSP(float, WS_SB_IN)); continue; } r -= I_IN2;
            if (r < I_IN3) { transpose_item<2, false>(Fw_in, N_IN, 8224, 544, F.ws + WS_BT_IN, D, 8192, scr, r, lane, cm_in, WSP(float, WS_SB_IN)); continue; } r -= I_IN3;
        }
        if (I8_O) { if (r < I_O) { transpose_item<2, false>(karg<I_WO>(), D, 0, 128, F.ws + WS_BT_O, D, 0, scr, r, lane, (unsigned*)(F.ws + WS_CM_O), WSP(float, WS_SB_O)); continue; } r -= I_O; }
        if (I8_UP) transpose_item<2, true>(Fw_up, 2 * DFF, 0, 688, F.ws + WS_BT_UP, D, 0, scr, r, lane, cm_up, WSP(float, WS_SB_UP));
    }
    if (I8_PROJ) {
        u32x4* z = (u32x4*)(F.ws + WS_BT_IN + (size_t)N_IN * D); const int nz = (N_IN_PAD - N_IN) * D / 16;
        for (int i = F.vcu * NTHR + F.tid; i < nz; i += F.G * NTHR) z[i] = (u32x4){0u, 0u, 0u, 0u};
        for (int i = F.vcu * NTHR + F.tid; i < N_IN_PAD - N_IN; i += F.G * NTHR) WSP(float, WS_SB_IN)[N_IN + i] = 0.f;
    }
}
__device__ __forceinline__ void phase0(Frame& F) {
    const int tid = F.tid, lane = F.lane, wave = F.wave;
    { const float* b_gate = karg<I_BGATE>(); const float* a_log = karg<I_ALOG>(); const float* dt_bias = karg<I_DTBIAS>(); float* sm = WSP(float, WS_SMALL);
      if (blockIdx.x == 0) { for (int i = tid; i < 8192; i += NTHR) sm[i] = b_gate[i]; if (tid < 16) { sm[8192 + tid] = a_log[tid]; sm[8192 + 16 + tid] = dt_bias[tid]; } } }
    {
        const float* Fc = karg<I_C>(); const float* Fw_ada = karg<I_WADA>(); const float* Fb_ada = karg<I_BADA>();
        LAS f32x4* sc = (LAS f32x4*)F.lds;
        LAS float* red = (LAS float*)(F.lds + 65536);
        for (int k = tid; k < D; k += NTHR) { f32x4 v; v.x = silu_(Fc[k]); v.y = silu_(Fc[D + k]); v.z = silu_(Fc[2 * D + k]); v.w = silu_(Fc[3 * D + k]); sc[k] = v; }
        __syncthreads();
        float* mod = WSP(float, WS_MOD);
        const int cg = lane & 7, slot = tid >> 3;
        for (int unit = F.vcu; unit < NMOD / 32; unit += F.G) {
            const int n0 = unit * 32;
            float acc[4][4];
#pragma unroll
            for (int b = 0; b < 4; ++b)
#pragma unroll
                for (int j = 0; j < 4; ++j) acc[b][j] = 0.f;
            const float* wp = Fw_ada + (size_t)slot * NMOD + n0 + 4 * cg;
#pragma unroll 8
            for (int it = 0; it < 64; ++it) { const f32x4 w = __builtin_nontemporal_load((const f32x4*)(wp + (size_t)it * 64 * NMOD)); const f32x4 s = sc[slot + 64 * it];
#pragma unroll
                for (int b = 0; b < 4; ++b)
#pragma unroll
                    for (int j = 0; j < 4; ++j) acc[b][j] += s[b] * w[j]; }
#pragma unroll
            for (int b = 0; b < 4; ++b)
#pragma unroll
                for (int j = 0; j < 4; ++j) { float v = acc[b][j]; v += __shfl_xor(v, 8); v += __shfl_xor(v, 16); v += __shfl_xor(v, 32); acc[b][j] = v; }
            if (lane < 8) {
#pragma unroll
                for (int b = 0; b < 4; ++b)
#pragma unroll
                    for (int j = 0; j < 4; ++j) red[(wave * 8 + lane) * 16 + b * 4 + j] = acc[b][j]; }
            __syncthreads();
            if (tid < 128) { const int cg2 = tid >> 4, idx = tid & 15; float s = 0.f;
#pragma unroll
                for (int w = 0; w < 8; ++w) s += red[(w * 8 + cg2) * 16 + idx];
                const int b = idx >> 2, j = idx & 3, n = n0 + 4 * cg2 + j;
                mod[(size_t)b * NMOD + n] = s + Fb_ada[n]; }
            __syncthreads();
        }
    }
    if (!I8_PROJ) { u32x4* z = (u32x4*)(WSP(bf16, WS_BT_IN) + (size_t)N_IN * D); const int nz = (N_IN_PAD - N_IN) * D / 8;
      for (int i = F.vcu * NTHR + tid; i < nz; i += F.G * NTHR) z[i] = (u32x4){0u, 0u, 0u, 0u}; }
    LAS float* scr = (LAS float*)(F.lds + wave * 8448);
    const int gw = F.vcu * NWAVES + wave, NGW = F.G * NWAVES;
    constexpr int I_A = 32 * 128, I_B = 16 * 128, I_DN = 172 * 128;
    constexpr int NITEMS = I_IN1 + I_IN2 + I_IN3 + I_A + I_B + I_O + I_UP + I_DN;
    bf16* bt_in = WSP(bf16, WS_BT_IN); unsigned* cm_in = (unsigned*)(F.ws + WS_CM_IN); unsigned* cm_up = (unsigned*)(F.ws + WS_CM_UP);
    const float* Fw_in = karg<I_WIN>(); const float* Fw_a = karg<I_WA>(); const float* Fw_b = karg<I_WB>(); const float* Fw_o = karg<I_WO>(); const float* Fw_up = karg<I_WUP>(); const float* Fw_down = karg<I_WDOWN>();
    constexpr int OI = I8_PROJ ? 1 : 0, OU = I8_UP ? 1 : 0, OO = I8_O ? 1 : 0;
    for (int it = gw; it < NITEMS; it += NGW) {
        int r = it;
        if (r < I_IN1) { transpose_item<OI, false>(Fw_in, N_IN, 0, 256, bt_in, D, 0, scr, r, lane, cm_in); continue; } r -= I_IN1;
        if (r < I_IN2) { transpose_item<OI, false>(Fw_in, N_IN, 8192, 1, bt_in, D, 25600, scr, r, lane, cm_in); continue; } r -= I_IN2;
        if (r < I_IN3) { transpose_item<OI, false>(Fw_in, N_IN, 8224, 544, bt_in, D, 8192, scr, r, lane, cm_in); continue; } r -= I_IN3;
#if CATAB
        if (r < I_A) { transpose_item<0, false>(Fw_a, D, 0, 128, WSP(bf16, WS_BT_A), 3072, 0, scr, r, lane); continue; } r -= I_A;
        if (r < I_B) { transpose_item<0, false>(Fw_b, D, 0, 128, WSP(bf16, WS_BT_A) + 2048, 3072, 0, scr, r, lane); continue; } r -= I_B;
#else
        if (r < I_A) { transpose_item<0, false>(Fw_a, D, 0, 128, WSP(bf16, WS_BT_A), 2048, 0, scr, r, lane); continue; } r -= I_A;
        if (r < I_B) { transpose_item<0, false>(Fw_b, D, 0, 128, WSP(bf16, WS_BT_B), 1024, 0, scr, r, lane); continue; } r -= I_B;
#endif
        if (r < I_O) { transpose_item<OO, false>(Fw_o, D, 0, 128, WSP(bf16, WS_BT_O), D, 0, scr, r, lane, (unsigned*)(F.ws + WS_CM_O)); continue; } r -= I_O;
        if (r < I_UP) { transpose_item<OU, true, true>(Fw_up, 2 * DFF, 0, 688, WSP(bf16, WS_BT_UP), D, 0, scr, r, lane, cm_up); continue; } r -= I_UP;
        transpose_item<0, false, true>(Fw_down, D, 0, 128, WSP(bf16, WS_BT_DN), DFF, 0, scr, r, lane);
    }
}

__device__ __forceinline__ void phase_quant_rows(Frame& F) {
    const int gw = F.vcu * NWAVES + F.wave, NGW = F.G * NWAVES, lane = F.lane;
    const bf16* TMb = WSP(bf16, WS_TM); unsigned char* Q = F.ws + WS_TMQ; const unsigned* rm = (const unsigned*)(F.ws + WS_RM_O); float* sA = WSP(float, WS_SA_O);
    for (int m = gw; m < M; m += NGW) {
        const float am = __uint_as_float(rm[m]), inv = am > 0.f ? 127.0f / am : 0.f;
        const u32x4* src = (const u32x4*)(TMb + (size_t)m * D) + lane; u32x2* dst = (u32x2*)(Q + (size_t)m * D) + lane;
#pragma unroll
        for (int j = 0; j < 8; ++j) { float f[8]; unpack8(__builtin_nontemporal_load(src + 64 * j), f);
#pragma unroll
            for (int e = 0; e < 8; ++e) f[e] = fminf(fmaxf(f[e] * inv, -127.f), 127.f);
            u32x2 w; w.x = q8x4(f[0], f[1], f[2], f[3], 1.0f); w.y = q8x4(f[4], f[5], f[6], f[7], 1.0f); dst[64 * j] = w; }
        if (lane == 0) sA[m] = am * (1.0f / 127.0f);
    }
}


__device__ __forceinline__ void phase_bg_mini(Frame& F) {
    typedef int i32x4 __attribute__((ext_vector_type(4)));
    const int lane = F.lane, wave = F.wave, g4 = lane >> 4, c16 = lane & 15;
    const unsigned char* Aq = F.ws + WS_H; const unsigned char* Bq = F.ws + WS_BT_IN + (size_t)25600 * D;
    const float* sA = WSP(float, WS_SA_IN); const float* sB = WSP(float, WS_SB_IN) + 25600; const float* small = WSP(float, WS_SMALL); float* bg = WSP(float, WS_BG);
    LAS i32x4* red = (LAS i32x4*)F.lds;
    for (int rb = F.vcu; rb < M / 64; rb += F.G) {
        const int m0 = rb * 64;
        i32x4 acc[4][2];
#pragma unroll
        for (int mt = 0; mt < 4; ++mt) { acc[mt][0] = (i32x4){0, 0, 0, 0}; acc[mt][1] = (i32x4){0, 0, 0, 0}; }
#pragma unroll 2
        for (int ks = 0; ks < 8; ++ks) { const int kb = (8 * wave + ks) * 64 + 16 * g4;
            i32x4 af[4], bf[2];
#pragma unroll
            for (int mt = 0; mt < 4; ++mt) af[mt] = *(const i32x4*)(Aq + (size_t)(m0 + 16 * mt + c16) * D + kb);
#pragma unroll
            for (int nt = 0; nt < 2; ++nt) bf[nt] = *(const i32x4*)(Bq + (size_t)(16 * nt + c16) * D + kb);
#pragma unroll
            for (int mt = 0; mt < 4; ++mt)
#pragma unroll
                for (int nt = 0; nt < 2; ++nt) acc[mt][nt] = __builtin_amdgcn_mfma_i32_16x16x64_i8(af[mt], bf[nt], acc[mt][nt], 0, 0, 0);
        }
        __syncthreads();
#pragma unroll
        for (int mt = 0; mt < 4; ++mt)
#pragma unroll
            for (int nt = 0; nt < 2; ++nt) red[(wave * 8 + mt * 2 + nt) * 64 + lane] = acc[mt][nt];
        __syncthreads();
        { const int mt = wave >> 1, nt = wave & 1;
          i32x4 s = (i32x4){0, 0, 0, 0};
#pragma unroll
          for (int w2 = 0; w2 < 8; ++w2) s = s + red[(w2 * 8 + wave) * 64 + lane];
          const int col = 16 * nt + c16, hh = col & 15; const float sb = sB[col];
          const float ea = -fexp(small[8192 + hh]), db = small[8192 + 16 + hh];
#pragma unroll
          for (int r = 0; r < 4; ++r) { const int row = m0 + 16 * mt + 4 * g4 + r; const float v = (float)s[r] * sA[row] * sb;
              const float o = (col < 16) ? __builtin_amdgcn_rcpf(1.0f + fexp(-v)) : ea * (fmaxf(v + db, 0.f) + log1pf(fexp(-fabsf(v + db))));
              bg[(size_t)row * 32 + col] = o; } }
    }
    __syncthreads();
}

__device__ __forceinline__ void phase_norm_mod_b16(Frame& F, const bf16* XB, int shift_chunk, int scale_chunk, bf16* H) {
    const int gw = F.vcu * NWAVES + F.wave, NGW = F.G * NWAVES, lane = F.lane;
    const float* mod = WSP(float, WS_MOD);
    const int rpw = (M + NGW - 1) / NGW, m0 = gw * rpw, m1 = (m0 + rpw < M) ? m0 + rpw : M;
    u32x4 v[8], nv[8]; f32x4 sc[16], sh[16]; int bcur = -1;
    if (m0 < m1) { const u32x4* xr = (const u32x4*)(XB + (size_t)m0 * D) + lane;
#pragma unroll
        for (int j = 0; j < 8; ++j) v[j] = __builtin_nontemporal_load(xr + 64 * j); }
    for (int m = m0; m < m1; ++m) {
        const int b = m >> 12;
        if (m + 1 < m1) { const u32x4* xn = (const u32x4*)(XB + (size_t)(m + 1) * D) + lane;
#pragma unroll
            for (int j = 0; j < 8; ++j) nv[j] = __builtin_nontemporal_load(xn + 64 * j); }
        if (b != bcur) { bcur = b;
            const f32x4* scp = (const f32x4*)(mod + (size_t)b * NMOD + scale_chunk * D) + 2 * lane;
            const f32x4* shp = (const f32x4*)(mod + (size_t)b * NMOD + shift_chunk * D) + 2 * lane;
#pragma unroll
            for (int j = 0; j < 8; ++j) { sc[2 * j] = scp[128 * j] + 1.0f; sc[2 * j + 1] = scp[128 * j + 1] + 1.0f; sh[2 * j] = shp[128 * j]; sh[2 * j + 1] = shp[128 * j + 1]; } }
        float ss = 0.f;
#pragma unroll
        for (int j = 0; j < 8; ++j) { float f[8]; unpack8(v[j], f);
#pragma unroll
            for (int e = 0; e < 8; ++e) ss += f[e] * f[e]; }
        const float rstd = rsqrtf(wave_sum(ss) * (1.f / D) + EPS);
        u32x4* o8 = (u32x4*)(H + (size_t)m * D) + lane;
#pragma unroll
        for (int j = 0; j < 8; ++j) { float f[8]; unpack8(v[j], f);
#pragma unroll
            for (int e = 0; e < 4; ++e) { f[e] = f[e] * rstd * sc[2 * j][e] + sh[2 * j][e]; f[4 + e] = f[4 + e] * rstd * sc[2 * j + 1][e] + sh[2 * j + 1][e]; }
            o8[64 * j] = pack8(f); }
#pragma unroll
        for (int j = 0; j < 8; ++j) v[j] = nv[j];
    }
}
template <bool ROPE, bool Q8> __device__ __forceinline__ void phase_norm_mod(Frame& F, const float* X, int shift_chunk, int scale_chunk, bf16* H, float* sA) {
    const int gw = F.vcu * NWAVES + F.wave, NGW = F.G * NWAVES, lane = F.lane;
    const float* mod = WSP(float, WS_MOD);
    const int* positions = ROPE ? (const int*)karg<I_POS>() : nullptr;
    const float invf = ROPE ? powf(500000.0f, -(float)(lane & 15) * (1.0f / 16.0f)) : 0.f;
    f32x4 v[16], nv[16];
    if (gw < M) { const f32x4* xr = (const f32x4*)(X + (size_t)gw * D) + lane;
#pragma unroll
        for (int j = 0; j < 16; ++j) v[j] = __builtin_nontemporal_load(xr + 64 * j); }
    for (int m = gw; m < M; m += NGW) {
        const int b = m >> 12;
        int posn = 0; if (ROPE) posn = positions[m];
        if (m + NGW < M) { const f32x4* xn = (const f32x4*)(X + (size_t)(m + NGW) * D) + lane;
#pragma unroll
            for (int j = 0; j < 16; ++j) nv[j] = __builtin_nontemporal_load(xn + 64 * j); }
        if (ROPE) { float sn, cs; sincosf((float)posn * invf, &sn, &cs); if (lane < 32) WSP(float, WS_ROPE)[(size_t)m * 32 + lane] = (lane < 16) ? cs : sn; }
        float ss = 0.f;
#pragma unroll
        for (int j = 0; j < 16; ++j) ss += (v[j].x * v[j].x + v[j].y * v[j].y) + (v[j].z * v[j].z + v[j].w * v[j].w);
        const float rstd = rsqrtf(wave_sum(ss) * (1.f / D) + EPS);
        const f32x4* scp = (const f32x4*)(mod + (size_t)b * NMOD + scale_chunk * D) + lane;
        const f32x4* shp = (const f32x4*)(mod + (size_t)b * NMOD + shift_chunk * D) + lane;
        if (Q8) {
            float am = 0.f;
#pragma unroll
            for (int j = 0; j < 16; ++j) { const f32x4 sc = scp[64 * j], sh = shp[64 * j]; v[j] = v[j] * rstd * (sc + 1.0f) + sh;
                am = fmaxf(am, fmaxf(fmaxf(fabsf(v[j].x), fabsf(v[j].y)), fmaxf(fabsf(v[j].z), fabsf(v[j].w)))); }
#pragma unroll
            for (int o = 1; o < 64; o <<= 1) am = fmaxf(am, __shfl_xor(am, o));
            const float inv = am > 0.f ? 127.0f / am : 0.f;
            unsigned* o4 = (unsigned*)((unsigned char*)H + (size_t)m * D) + lane;
#pragma unroll
            for (int j = 0; j < 16; ++j) o4[64 * j] = q8x4(v[j].x, v[j].y, v[j].z, v[j].w, inv);
            if (lane == 0) sA[m] = am * (1.0f / 127.0f);
        } else {
        u32x2* o8 = (u32x2*)(H + (size_t)m * D) + lane;
#pragma unroll
        for (int j = 0; j < 16; ++j) { const f32x4 sc = scp[64 * j], sh = shp[64 * j]; const f32x4 o = v[j] * rstd * (sc + 1.0f) + sh;
            u32x2 w; w.x = pk2(o.x, o.y); w.y = pk2(o.z, o.w); o8[64 * j] = w; }
        }
#pragma unroll
        for (int j = 0; j < 16; ++j) v[j] = nv[j];
    }
}


__device__ __forceinline__ bf16x8 ldfrag_sw(const LAS unsigned char* base, int row0, int k0, int lane) {
    const int chunk = (k0 >> 3) + (lane >> 4), sw = (row0 >> 4) & 7;
    return *(const LAS bf16x8*)(base + (row0 + (lane & 15)) * 144 + ((chunk ^ sw) << 4));
}
template <int J> __device__ __forceinline__ void d1_solve_steps(float (&Tr)[16], const float (&Ar)[16]) {
    if constexpr (J < 15) {
#pragma unroll
        for (int c = 0; c <= J; ++c) {
            const float tj = __builtin_bit_cast(float, __builtin_amdgcn_update_dpp(0, __builtin_bit_cast(int, Tr[c]), 0x150 + J, 0xf, 0xf, false));
            Tr[c] -= Ar[J] * tj; }
        d1_solve_steps<J + 1>(Tr, Ar);
    }
}
constexpr int D1_QN = 0, D1_KN = 17408, D1_VBT = 34816, D1_KBDT = 53248, D1_KDT = 71680, D1_AM = 90112, D1_TM = 107520, D1_SC = 116736, D1_TT = 117504, D1_CW = 134912;
__device__ __forceinline__ void d1_load_cw(Frame& F, int h) {
    const float* conv_qkv = karg<I_CONVQKV>(); LAS float* cwl = (LAS float*)(F.lds + D1_CW);
    for (int i = F.tid; i < 1536; i += NTHR) { const int j = i / 384, rem = i - j * 384, which = rem >> 7, d = rem & 127; cwl[i] = conv_qkv[j * 6144 + which * 2048 + h * 128 + d]; }
    __syncthreads();
}
__device__ __forceinline__ void d1_item(Frame& F, int ci, int& cached_h) {
    const int tid = F.tid, lane = F.lane, wave = F.wave, g4 = lane >> 4, c16 = lane & 15;
    const int h = ci & 15, n = (ci >> 4) & 63, b = ci >> 10;
    const int m0 = b * T + n * 64;
    if (h != cached_h) { d1_load_cw(F, h); cached_h = h; }
    LAS unsigned char* L = F.lds;
    LAS float* sc_beta = (LAS float*)(L + D1_SC); LAS float* sc_gc = sc_beta + 64;
    LAS float* AM = (LAS float*)(L + D1_AM);
    unsigned char* outp = F.ws + WS_D1 + (size_t)((b * 16 + h) * 64 + n) * D1_CHUNK_BYTES;
    bf16* Wg = (bf16*)outp; bf16* QDg = (bf16*)(outp + 16384); bf16* KDTg = (bf16*)(outp + 32768); u32x2* UFg = (u32x2*)(outp + 49152); bf16* AQKg = (bf16*)(outp + 65536);
    const float* bg = WSP(float, WS_BG);
    u32x4 raw[3][4][2];
#define D1_LOAD_RAW(which) do { const int tok_ = tid >> 3, sub_ = tid & 7, t_ = n * 64 + tok_; const bf16* qkva_ = WSP(bf16, WS_QKVA); \
        _Pragma("unroll") for (int j = 0; j < 4; ++j) { raw[which][j][0] = (u32x4){0u, 0u, 0u, 0u}; raw[which][j][1] = (u32x4){0u, 0u, 0u, 0u}; \
            if (t_ - 3 + j >= 0) { const bf16* rp = qkva_ + (size_t)(m0 + tok_ - 3 + j) * 6144 + (which) * 2048 + h * 128 + 16 * sub_; raw[which][j][0] = *(const u32x4*)rp; raw[which][j][1] = *(const u32x4*)(rp + 8); } } } while (0)
    D1_LOAD_RAW(0); D1_LOAD_RAW(1);
    if (wave == 0) {
        const float be = bg[(size_t)(m0 + lane) * 32 + h]; float gc = bg[(size_t)(m0 + lane) * 32 + 16 + h];
#pragma unroll
        for (int o = 1; o < 64; o <<= 1) { const float t = __shfl_up(gc, o); if (lane >= o) gc += t; }
        sc_beta[lane] = be; sc_gc[lane] = gc;
    }
    __syncthreads();
    const float glast = sc_gc[63];
    {
        const int tok = tid >> 3, sub = tid & 7, t = n * 64 + tok;
        const float be = sc_beta[tok], gc = sc_gc[tok];
        const float eg = fexp(gc), ekd = fexp(glast - gc);
        const int tsw = (((tok >> 3) ^ sub) << 4) + (tok & 7) * 2;
#pragma unroll
        for (int which = 0; which < 3; ++which) {
            const int ch0 = which * 2048 + h * 128 + 16 * sub;
            float a[16];
#pragma unroll
            for (int e = 0; e < 16; ++e) a[e] = 0.f;
#pragma unroll
            for (int j = 0; j < 4; ++j) {
                float x[16]; { float t0[8], t1[8]; unpack8(raw[which][j][0], t0); unpack8(raw[which][j][1], t1);
#pragma unroll
                    for (int e = 0; e < 8; ++e) { x[e] = t0[e]; x[8 + e] = t1[e]; } }
                const LAS f32x4* cw = (const LAS f32x4*)(L + D1_CW + ((j * 3 + which) * 128 + 16 * sub) * 4);
#pragma unroll
                for (int q = 0; q < 4; ++q) { const f32x4 w = cw[q];
#pragma unroll
                    for (int e = 0; e < 4; ++e) a[4 * q + e] += w[e] * x[4 * q + e]; }
            }
            float ss = 0.f;
#pragma unroll
            for (int e = 0; e < 16; ++e) { a[e] = silu_(a[e]); ss += a[e] * a[e]; }
            if (which < 2) {
                ss += __shfl_xor(ss, 1); ss += __shfl_xor(ss, 2); ss += __shfl_xor(ss, 4);
                const float rs = rsqrtf(ss + EPS) * (which == 0 ? 0.08838834764831845f : 1.0f);
#pragma unroll
                for (int e = 0; e < 16; ++e) a[e] *= rs;
            }
            if (which == 0) {
                asm volatile("" ::: "memory"); D1_LOAD_RAW(2);
                float lo[8], hi[8];
#pragma unroll
                for (int e = 0; e < 8; ++e) { lo[e] = a[e]; hi[e] = a[8 + e]; }
                *(LAS u32x4*)(L + D1_QN + tok * 272 + sub * 32) = pack8(lo); *(LAS u32x4*)(L + D1_QN + tok * 272 + sub * 32 + 16) = pack8(hi);
#pragma unroll
                for (int e = 0; e < 8; ++e) { lo[e] *= eg; hi[e] *= eg; }
                *(u32x4*)(QDg + tok * 128 + 16 * sub) = pack8(lo); *(u32x4*)(QDg + tok * 128 + 16 * sub + 8) = pack8(hi);
            } else if (which == 1) {
                float lo[8], hi[8];
#pragma unroll
                for (int e = 0; e < 8; ++e) { lo[e] = a[e]; hi[e] = a[8 + e]; }
                *(LAS u32x4*)(L + D1_KN + tok * 272 + sub * 32) = pack8(lo); *(LAS u32x4*)(L + D1_KN + tok * 272 + sub * 32 + 16) = pack8(hi);
                const float f1 = be * eg;
#pragma unroll
                for (int e = 0; e < 16; ++e) {
                    *(LAS bf16*)(L + D1_KBDT + (16 * sub + e) * 144 + tsw) = (bf16)f2bf(a[e] * f1);
                    *(LAS bf16*)(L + D1_KDT + (16 * sub + e) * 144 + tsw) = (bf16)f2bf(a[e] * ekd); }
            } else {
#pragma unroll
                for (int e = 0; e < 16; ++e) *(LAS bf16*)(L + D1_VBT + (16 * sub + e) * 144 + tsw) = (bf16)f2bf(a[e] * be);
            }
        }
    }
    __syncthreads();
#pragma unroll
    for (int tt = 0; tt < 2; ++tt) {
        const int tix = wave + 8 * tt, ti = tix >> 2, tj = tix & 3;
        if (tj <= ti) {
            f32x4 acc = (f32x4){0.f, 0.f, 0.f, 0.f}, acc2 = (f32x4){0.f, 0.f, 0.f, 0.f};
#pragma unroll
            for (int s = 0; s < 4; ++s) {
                const bf16x8 ki = ldfrag(L + D1_KN, 272, 16 * ti, 32 * s, lane), kj = ldfrag(L + D1_KN, 272, 16 * tj, 32 * s, lane), qi = ldfrag(L + D1_QN, 272, 16 * ti, 32 * s, lane);
                acc = MFMA16(ki, kj, acc);
                acc2 = MFMA16(kj, qi, acc2);
            }
            { const int j = 16 * tj + c16; const float gcj = sc_gc[j];
#pragma unroll
              for (int r = 0; r < 4; ++r) { const int i = 16 * ti + 4 * g4 + r; const bool ok = i > j;
                  const float v = ok ? sc_beta[i] * fexp(sc_gc[i] - gcj) * acc[r] : 0.f; AM[i * 68 + j] = v; } }
            { const int i = 16 * ti + c16; const float gci = sc_gc[i]; float v[4];
#pragma unroll
              for (int r = 0; r < 4; ++r) { const int j = 16 * tj + 4 * g4 + r; const bool ok = i >= j; v[r] = ok ? fexp(gci - sc_gc[j]) * acc2[r] : 0.f; }
              u32x2 w; w.x = pk2(v[0], v[1]); w.y = pk2(v[2], v[3]); *(u32x2*)(AQKg + i * 64 + 16 * tj + 4 * g4) = w; }
        } else {
            *(u32x2*)(AQKg + (16 * ti + c16) * 64 + 16 * tj + 4 * g4) = (u32x2){0u, 0u};
        }
    }
#pragma unroll
    for (int i = 0; i < 2; ++i) { const int q = tid + NTHR * i, row = q >> 3, cc = q & 7;
        *(u32x4*)(KDTg + row * 64 + 8 * cc) = *(const LAS u32x4*)(L + D1_KDT + row * 144 + 16 * (cc ^ ((row >> 4) & 7))); }
    if (tid == 0) WSP(float, WS_DEC)[(b * 16 + h) * 64 + n] = fexp(glast);
    __syncthreads();
    LAS float* TT = (LAS float*)(L + D1_TT);
    if (wave == 0) {
        const int blk = g4, i = c16;
        float Ar[16], Tr[16];
#pragma unroll
        for (int q = 0; q < 4; ++q) { const f32x4 v = *(const LAS f32x4*)(AM + (16 * blk + i) * 68 + 16 * blk + 4 * q); Ar[4 * q] = v[0]; Ar[4 * q + 1] = v[1]; Ar[4 * q + 2] = v[2]; Ar[4 * q + 3] = v[3]; }
#pragma unroll
        for (int c = 0; c < 16; ++c) Tr[c] = (c == i) ? 1.f : 0.f;
        d1_solve_steps<0>(Tr, Ar);
#pragma unroll
        for (int q = 0; q < 4; ++q) *(LAS f32x4*)(TT + (16 * blk + i) * 68 + 16 * blk + 4 * q) = (f32x4){Tr[4 * q], Tr[4 * q + 1], Tr[4 * q + 2], Tr[4 * q + 3]};
    }
    __syncthreads();
#pragma unroll
    for (int d = 1; d < 4; ++d) {
        if (wave < 4 - d) {
            const int bi = wave + d, bj = wave;
            f32x4 S = (f32x4){0.f, 0.f, 0.f, 0.f};
#pragma unroll
            for (int kk = 0; kk < d; ++kk) { const int k = bj + kk;
#pragma unroll
                for (int s4 = 0; s4 < 4; ++s4) S = __builtin_amdgcn_mfma_f32_16x16x4f32(AM[(16 * bi + c16) * 68 + 16 * k + 4 * s4 + g4], TT[(16 * k + 4 * s4 + g4) * 68 + 16 * bj + c16], S, 0, 0, 0); }
            f32x4 R = (f32x4){0.f, 0.f, 0.f, 0.f};
#pragma unroll
            for (int s4 = 0; s4 < 4; ++s4) R = __builtin_amdgcn_mfma_f32_16x16x4f32(TT[(16 * bi + c16) * 68 + 16 * bi + 4 * g4 + s4], S[s4], R, 0, 0, 0);
#pragma unroll
            for (int r = 0; r < 4; ++r) TT[(16 * bi + 4 * g4 + r) * 68 + 16 * bj + c16] = -R[r];
        }
        __syncthreads();
    }
    { const int row = tid >> 3, col0 = (tid & 7) * 8; const bool up = (col0 >> 4) > (row >> 4);
      const f32x4 v0 = *(const LAS f32x4*)(TT + row * 68 + col0), v1 = *(const LAS f32x4*)(TT + row * 68 + col0 + 4);
      u32x4 w; w.x = pk2(v0[0], v0[1]); w.y = pk2(v0[2], v0[3]); w.z = pk2(v1[0], v1[1]); w.w = pk2(v1[2], v1[3]);
      if (up) w = (u32x4){0u, 0u, 0u, 0u};
      *(LAS u32x4*)(L + D1_TM + row * 144 + col0 * 2) = w; }
    __syncthreads();
#pragma unroll
    for (int ti = 0; ti < 4; ++ti) {
        f32x4 au = (f32x4){0.f, 0.f, 0.f, 0.f}, aw = (f32x4){0.f, 0.f, 0.f, 0.f};
#pragma unroll
        for (int s = 0; s < 2; ++s) {
            const bf16x8 tf = ldfrag(L + D1_TM, 144, 16 * ti, 32 * s, lane);
            au = MFMA16(tf, ldfrag_sw(L + D1_VBT, 16 * wave, 32 * s, lane), au);
            aw = MFMA16(ldfrag_sw(L + D1_KBDT, 16 * wave, 32 * s, lane), tf, aw);
        }
        u32x2 w; w.x = pk2(au[0], au[1]); w.y = pk2(au[2], au[3]); UFg[(ti * 8 + wave) * 64 + lane] = w;
        w.x = pk2(aw[0], aw[1]); w.y = pk2(aw[2], aw[3]); *(u32x2*)(Wg + (16 * ti + c16) * 128 + 16 * wave + 4 * g4) = w;
    }
    __syncthreads();
}

constexpr int D2_W = 0, D2_QD = 17408, D2_KDT = 34816, D2_AQK = 53248, D2_ST = 62464, D2_VNT = 97280;
__device__ __forceinline__ void d2_item(Frame& F, int bh) {
    const int tid = F.tid, lane = F.lane, wave = F.wave, g4 = lane >> 4, c16 = lane & 15;
    const int b = bh >> 4, h = bh & 15;
    LAS unsigned char* L = F.lds;
    const unsigned char* seq = F.ws + WS_D1 + (size_t)bh * 64 * D1_CHUNK_BYTES;
    const float* dec = WSP(float, WS_DEC) + bh * 64;
    bf16* OA = WSP(bf16, WS_OA);
    for (int i = tid; i < 34816 / 16; i += NTHR) *(LAS u32x4*)(L + D2_ST + 16 * i) = (u32x4){0u, 0u, 0u, 0u};
    if (wave >= 4) {
        const int lt = tid - 256;
        u32x4 pw[4], pq[4], pk[4], pa[2];
#define D2_LOAD(nn) do { const unsigned char* cp = seq + (size_t)(nn) * D1_CHUNK_BYTES; \
            _Pragma("unroll") for (int i = 0; i < 4; ++i) { const int q = lt + 256 * i; pw[i] = *(const u32x4*)(cp + 16 * q); pq[i] = *(const u32x4*)(cp + 16384 + 16 * q); pk[i] = *(const u32x4*)(cp + 32768 + 16 * q); } \
            _Pragma("unroll") for (int i = 0; i < 2; ++i) pa[i] = *(const u32x4*)(cp + 65536 + 16 * (lt + 256 * i)); } while (0)
        D2_LOAD(0);
        for (int n = 0; n < 64; ++n) {
            __syncthreads();
#pragma unroll
            for (int i = 0; i < 4; ++i) { const int q = lt + 256 * i;
                *(LAS u32x4*)(L + D2_W + (q >> 4) * 272 + (q & 15) * 16) = pw[i]; *(LAS u32x4*)(L + D2_QD + (q >> 4) * 272 + (q & 15) * 16) = pq[i];
                *(LAS u32x4*)(L + D2_KDT + (q >> 3) * 144 + (q & 7) * 16) = pk[i]; }
#pragma unroll
            for (int i = 0; i < 2; ++i) { const int q = lt + 256 * i; *(LAS u32x4*)(L + D2_AQK + (q >> 3) * 144 + (q & 7) * 16) = pa[i]; }
            __syncthreads();
            if (n + 1 < 64) D2_LOAD(n + 1);
        }
#undef D2_LOAD
    } else {
        f32x4 sacc[8][2];
#pragma unroll
        for (int k = 0; k < 8; ++k) { sacc[k][0] = (f32x4){0.f, 0.f, 0.f, 0.f}; sacc[k][1] = (f32x4){0.f, 0.f, 0.f, 0.f}; }
        u32x2 pu[4][2]; float pdec;
#define D2_LOADU(nn) do { const unsigned char* cp = seq + (size_t)(nn) * D1_CHUNK_BYTES; \
            _Pragma("unroll") for (int ti = 0; ti < 4; ++ti) _Pragma("unroll") for (int dt = 0; dt < 2; ++dt) pu[ti][dt] = *(const u32x2*)(cp + 49152 + ((ti * 8 + 2 * wave + dt) * 64 + lane) * 8); \
            pdec = dec[nn]; } while (0)
        D2_LOADU(0);
        for (int n = 0; n < 64; ++n) {
            __syncthreads();
            const float decay = pdec;
            __syncthreads();
        bf16x8 bS[4][2];
#pragma unroll
        for (int s = 0; s < 4; ++s)
#pragma unroll
            for (int dt = 0; dt < 2; ++dt) bS[s][dt] = ldfrag(L + D2_ST, 272, 16 * (2 * wave + dt), 32 * s, lane);
#pragma unroll
        for (int ti = 0; ti < 4; ++ti) {
            f32x4 va[2] = {(f32x4){0.f, 0.f, 0.f, 0.f}, (f32x4){0.f, 0.f, 0.f, 0.f}};
#pragma unroll
            for (int s = 0; s < 4; ++s) { const bf16x8 wf = ldfrag(L + D2_W, 272, 16 * ti, 32 * s, lane);
                va[0] = MFMA16(wf, bS[s][0], va[0]); va[1] = MFMA16(wf, bS[s][1], va[1]); }
#pragma unroll
            for (int dt = 0; dt < 2; ++dt) {
                const float v0 = bflo(pu[ti][dt].x) - va[dt][0], v1 = bfhi(pu[ti][dt].x) - va[dt][1], v2 = bflo(pu[ti][dt].y) - va[dt][2], v3 = bfhi(pu[ti][dt].y) - va[dt][3];
                u32x2 w; w.x = pk2(v0, v1); w.y = pk2(v2, v3);
                *(LAS u32x2*)(L + D2_VNT + (16 * (2 * wave + dt) + c16) * 144 + (16 * ti + 4 * g4) * 2) = w; }
        }
        if (n + 1 < 64) D2_LOADU(n + 1);
        bf16x8 bV[2][2];
#pragma unroll
        for (int s2 = 0; s2 < 2; ++s2)
#pragma unroll
            for (int dt = 0; dt < 2; ++dt) bV[s2][dt] = ldfrag(L + D2_VNT, 144, 16 * (2 * wave + dt), 32 * s2, lane);
#pragma unroll
        for (int ti = 0; ti < 4; ++ti) {
            f32x4 oa[2] = {(f32x4){0.f, 0.f, 0.f, 0.f}, (f32x4){0.f, 0.f, 0.f, 0.f}};
#pragma unroll
            for (int s = 0; s < 4; ++s) { const bf16x8 qf = ldfrag(L + D2_QD, 272, 16 * ti, 32 * s, lane);
                oa[0] = MFMA16(bS[s][0], qf, oa[0]); oa[1] = MFMA16(bS[s][1], qf, oa[1]); }
#pragma unroll
            for (int s2 = 0; s2 < 2; ++s2) { const bf16x8 af = ldfrag(L + D2_AQK, 144, 16 * ti, 32 * s2, lane);
                oa[0] = MFMA16(bV[s2][0], af, oa[0]); oa[1] = MFMA16(bV[s2][1], af, oa[1]); }
#pragma unroll
            for (int dt = 0; dt < 2; ++dt) { u32x2 w; w.x = pk2(oa[dt][0], oa[dt][1]); w.y = pk2(oa[dt][2], oa[dt][3]);
                *(u32x2*)(OA + (size_t)(b * T + n * 64 + 16 * ti + c16) * 2048 + h * 128 + 16 * (2 * wave + dt) + 4 * g4) = w; }
        }
#pragma unroll
        for (int k = 0; k < 8; ++k) {
            const bf16x8 k0 = ldfrag(L + D2_KDT, 144, 16 * k, 0, lane), k1 = ldfrag(L + D2_KDT, 144, 16 * k, 32, lane);
#pragma unroll
            for (int dt = 0; dt < 2; ++dt) {
                f32x4 sa = sacc[k][dt] * decay;
                sa = MFMA16(k0, bV[0][dt], sa);
                sa = MFMA16(k1, bV[1][dt], sa);
                sacc[k][dt] = sa;
                u32x2 w; w.x = pk2(sa[0], sa[1]); w.y = pk2(sa[2], sa[3]);
                *(LAS u32x2*)(L + D2_ST + (16 * (2 * wave + dt) + c16) * 272 + (16 * k + 4 * g4) * 2) = w; }
        }
        }
#undef D2_LOADU
    }
    __syncthreads();
}

constexpr int SW_KT = 0, SW_VT = 69632;
#define TR_READ16(o, a0, a1) asm volatile( \
    "ds_read_b64_tr_b16 %0, %16\n\tds_read_b64_tr_b16 %1, %17\n\tds_read_b64_tr_b16 %2, %16 offset:32\n\tds_read_b64_tr_b16 %3, %17 offset:32\n\t" \
    "ds_read_b64_tr_b16 %4, %16 offset:64\n\tds_read_b64_tr_b16 %5, %17 offset:64\n\tds_read_b64_tr_b16 %6, %16 offset:96\n\tds_read_b64_tr_b16 %7, %17 offset:96\n\t" \
    "ds_read_b64_tr_b16 %8, %16 offset:128\n\tds_read_b64_tr_b16 %9, %17 offset:128\n\tds_read_b64_tr_b16 %10, %16 offset:160\n\tds_read_b64_tr_b16 %11, %17 offset:160\n\t" \
    "ds_read_b64_tr_b16 %12, %16 offset:192\n\tds_read_b64_tr_b16 %13, %17 offset:192\n\tds_read_b64_tr_b16 %14, %16 offset:224\n\tds_read_b64_tr_b16 %15, %17 offset:224\n\t" \
    "s_waitcnt lgkmcnt(0)" \
    : "=&v"(o[0]), "=&v"(o[1]), "=&v"(o[2]), "=&v"(o[3]), "=&v"(o[4]), "=&v"(o[5]), "=&v"(o[6]), "=&v"(o[7]), "=&v"(o[8]), "=&v"(o[9]), "=&v"(o[10]), "=&v"(o[11]), "=&v"(o[12]), "=&v"(o[13]), "=&v"(o[14]), "=&v"(o[15]) \
    : "v"(a0), "v"(a1) : "memory")
__device__ __forceinline__ void swa_unit(Frame& F, int u) {
    const int tid = F.tid, lane = F.lane, wave = F.wave, g4 = lane >> 4, c16 = lane & 15;
    const int b = u / 768, rem = u - b * 768, grp = rem >> 8, rem2 = rem & 255, h = rem2 >> 5, xx = rem2 & 31;
    const int dsh = 2 * grp, dil = 1 << dsh, nbsh = 5 - dsh;
    const int r = xx >> nbsh, ib = xx & ((1 << nbsh) - 1);
    LAS unsigned char* L = F.lds;
    const bf16* qkvb = WSP(bf16, WS_QKVB);
    const size_t colq = (size_t)grp * 3072 + h * 128, colk = colq + 1024, colv = colq + 2048;
    const float* k_gain = karg<I_KGAIN>(); const float* q_gain = karg<I_QGAIN>(); const float* rope = WSP(float, WS_ROPE);
    u32x4 kraw[2][4], vraw[8];
#pragma unroll
    for (int pass = 0; pass < 2; ++pass) { const int key = 128 * pass + (tid >> 2), qd = tid & 3, nk = 128 * (ib - 1) + key;
#pragma unroll
        for (int q = 0; q < 4; ++q) kraw[pass][q] = (u32x4){0u, 0u, 0u, 0u};
        if (nk >= 0) { const bf16* kp = qkvb + (size_t)(b * T + r + dil * nk) * 9216 + colk + 32 * qd;
#pragma unroll
            for (int q = 0; q < 4; ++q) kraw[pass][q] = *(const u32x4*)(kp + 8 * q); } }
#pragma unroll
    for (int i = 0; i < 8; ++i) { const int q = tid + NTHR * i, key = q >> 4, cc = q & 15; const int nk = 128 * (ib - 1) + key;
        vraw[i] = (u32x4){0u, 0u, 0u, 0u};
        if (nk >= 0) vraw[i] = *(const u32x4*)(qkvb + (size_t)(b * T + r + dil * nk) * 9216 + colv + 8 * cc); }
#pragma unroll
    for (int pass = 0; pass < 2; ++pass) {
        const int key = 128 * pass + (tid >> 2), qd = tid & 3;
        const int nk = 128 * (ib - 1) + key;
        u32x4 outw[4];
        if (nk >= 0) {
            const int mk = b * T + r + dil * nk;
            float v[32]; float ss = 0.f;
#pragma unroll
            for (int q = 0; q < 4; ++q) { float t8[8]; unpack8(kraw[pass][q], t8);
#pragma unroll
                for (int e = 0; e < 8; ++e) { v[8 * q + e] = t8[e]; ss += t8[e] * t8[e]; } }
            ss += __shfl_xor(ss, 1); ss += __shfl_xor(ss, 2);
            const float rstd = rsqrtf(ss * (1.f / 128.f) + EPS);
            const float* gp = k_gain + 32 * qd;
#pragma unroll
            for (int e = 0; e < 32; ++e) v[e] *= rstd * gp[e];
            if (qd == 0) {
                const f32x4* rt = (const f32x4*)(rope + (size_t)mk * 32);
#pragma unroll
                for (int q = 0; q < 4; ++q) { const f32x4 cs = rt[q], sn = rt[4 + q];
#pragma unroll
                    for (int e = 0; e < 4; ++e) { const int j = 4 * q + e; const float x1 = v[j], x2 = v[16 + j]; v[j] = x1 * cs[e] - x2 * sn[e]; v[16 + j] = x2 * cs[e] + x1 * sn[e]; } }
            }
#pragma unroll
            for (int q = 0; q < 4; ++q) { float t8[8];
#pragma unroll
                for (int e = 0; e < 8; ++e) t8[e] = v[8 * q + e];
                outw[q] = pack8(t8); }
        } else {
#pragma unroll
            for (int q = 0; q < 4; ++q) outw[q] = (u32x4){0u, 0u, 0u, 0u};
        }
#pragma unroll
        for (int q = 0; q < 4; ++q) *(LAS u32x4*)(L + SW_KT + key * 272 + qd * 64 + 16 * q) = outw[q];
    }
#pragma unroll
    for (int i = 0; i < 8; ++i) { const int q = tid + NTHR * i, key = q >> 4, cc = q & 15; *(LAS u32x4*)(L + SW_VT + key * 272 + 16 * cc) = vraw[i]; }
    const int qi = 16 * wave + c16;
    const int mq = b * T + r + dil * (128 * ib + qi);
    bf16x8 qf[4];
    {
        const bf16* qp = qkvb + (size_t)mq * 9216 + colq + 8 * g4;
        float v[4][8]; float ss = 0.f;
#pragma unroll
        for (int s = 0; s < 4; ++s) { unpack8(*(const u32x4*)(qp + 32 * s), v[s]);
#pragma unroll
            for (int e = 0; e < 8; ++e) ss += v[s][e] * v[s][e]; }
        ss += __shfl_xor(ss, 16); ss += __shfl_xor(ss, 32);
        const float rstd = rsqrtf(ss * (1.f / 128.f) + EPS);
#pragma unroll
        for (int s = 0; s < 4; ++s)
#pragma unroll
            for (int e = 0; e < 8; ++e) v[s][e] *= rstd * q_gain[32 * s + 8 * g4 + e];
        const f32x4* rt = (const f32x4*)(rope + (size_t)mq * 32 + 8 * (g4 & 1));
        const f32x4 c0 = rt[0], c1 = rt[1], s0 = rt[4], s1 = rt[5];
#pragma unroll
        for (int e = 0; e < 8; ++e) { const float cs = e < 4 ? c0[e & 3] : c1[e & 3], sn = e < 4 ? s0[e & 3] : s1[e & 3];
            const float xo = v[0][e], xp = __shfl_xor(xo, 32);
            v[0][e] = (g4 < 2) ? (xo * cs - xp * sn) : (xo * cs + xp * sn); }
#pragma unroll
        for (int s = 0; s < 4; ++s) { float t8[8];
#pragma unroll
            for (int e = 0; e < 8; ++e) t8[e] = v[s][e] * 0.08838834764831845f;
            const u32x4 w = pack8(t8); qf[s] = __builtin_bit_cast(bf16x8, w); }
    }
    __syncthreads();
    f32x4 sacc[9];
#pragma unroll
    for (int kk = 0; kk < 9; ++kk) { f32x4 a = (f32x4){0.f, 0.f, 0.f, 0.f};
#pragma unroll
        for (int s = 0; s < 4; ++s) a = MFMA16(ldfrag(L + SW_KT, 272, 16 * (wave + kk), 32 * s, lane), qf[s], a);
        sacc[kk] = a; }
    float mx = -INFINITY;
#pragma unroll
    for (int kk = 0; kk < 9; ++kk)
#pragma unroll
        for (int rr = 0; rr < 4; ++rr) { const int ki = 16 * (wave + kk) + 4 * g4 + rr; const bool ok = (ki >= qi) && (ki <= qi + 128) && (ib > 0 || ki >= 128);
            const float sv = ok ? sacc[kk][rr] : -INFINITY; sacc[kk][rr] = sv; mx = fmaxf(mx, sv); }
    mx = fmaxf(mx, __shfl_xor(mx, 16)); mx = fmaxf(mx, __shfl_xor(mx, 32));
    float den = 0.f;
#pragma unroll
    for (int kk = 0; kk < 9; ++kk)
#pragma unroll
        for (int rr = 0; rr < 4; ++rr) { const float p = fexp(sacc[kk][rr] - mx); sacc[kk][rr] = p; den += p; }
    den += __shfl_xor(den, 16); den += __shfl_xor(den, 32);
    const float rden = __builtin_amdgcn_rcpf(den);
    f32x4 oacc[8];
#pragma unroll
    for (int dt = 0; dt < 8; ++dt) oacc[dt] = (f32x4){0.f, 0.f, 0.f, 0.f};
    typedef short s16x4 __attribute__((ext_vector_type(4)));
    const LAS unsigned char* vlane = L + SW_VT + ((c16 >> 2) * 272) + (c16 & 3) * 8;
#pragma unroll
    for (int pp = 0; pp < 5; ++pp) {
        u32x4 pw; pw.x = pk2(sacc[2 * pp][0], sacc[2 * pp][1]); pw.y = pk2(sacc[2 * pp][2], sacc[2 * pp][3]);
        if (pp < 4) { pw.z = pk2(sacc[2 * pp + 1][0], sacc[2 * pp + 1][1]); pw.w = pk2(sacc[2 * pp + 1][2], sacc[2 * pp + 1][3]); } else { pw.z = 0u; pw.w = 0u; }
        const bf16x8 pf = __builtin_bit_cast(bf16x8, pw);
        const int t0 = wave + 2 * pp; const int t1 = (t0 + 1 > 15) ? 15 : (t0 + 1);
        const LAS unsigned char* a0 = vlane + (16 * t0 + 4 * g4) * 272; const LAS unsigned char* a1 = vlane + (16 * t1 + 4 * g4) * 272;
#pragma unroll
        for (int dt = 0; dt < 8; ++dt) {
            const s16x4 lo = __builtin_amdgcn_ds_read_tr16_b64_v4i16((LAS s16x4*)(a0 + 32 * dt)), hi = __builtin_amdgcn_ds_read_tr16_b64_v4i16((LAS s16x4*)(a1 + 32 * dt));
            oacc[dt] = MFMA16(__builtin_shufflevector(lo, hi, 0, 1, 2, 3, 4, 5, 6, 7), pf, oacc[dt]); }
    }
    bf16* so = WSP(bf16, WS_SWAO) + (size_t)grp * M * 1024 + (size_t)mq * 1024 + h * 128 + 4 * g4;
#pragma unroll
    for (int dt = 0; dt < 8; ++dt) { u32x2 w; w.x = pk2(oacc[dt][0] * rden, oacc[dt][1] * rden); w.y = pk2(oacc[dt][2] * rden, oacc[dt][3] * rden); *(u32x2*)(so + 16 * dt) = w; }
    if (g4 == 0) WSP(float, WS_LSE)[((size_t)grp * M + mq) * 8 + h] = mx + 0.6931471805599453f * __builtin_amdgcn_logf(den);
    __syncthreads();
}

struct MergeRow { u32x4 oa[4], z[4], so[2][3]; float l[2][3]; };
__device__ __forceinline__ void merge_load(MergeRow& R, int m, int lane, const bf16* OA, const bf16* Z, const bf16* SO, const float* LSE) {
#pragma unroll
    for (int j = 0; j < 4; ++j) { const int col = 512 * j + 8 * lane;
        R.oa[j] = __builtin_nontemporal_load((const u32x4*)(OA + (size_t)m * 2048 + col)); R.z[j] = __builtin_nontemporal_load((const u32x4*)(Z + (size_t)m * 2048 + col)); }
#pragma unroll
    for (int j = 0; j < 2; ++j) { const int col = 512 * j + 8 * lane, head = col >> 7;
#pragma unroll
        for (int g = 0; g < 3; ++g) { R.l[j][g] = LSE[((size_t)g * M + m) * 8 + head]; R.so[j][g] = __builtin_nontemporal_load((const u32x4*)(SO + ((size_t)g * M + m) * 1024 + col)); } }
}
__device__ __forceinline__ void merge_finish(const MergeRow& R, int m, int lane, const float* o_gain, bf16* OAN, bf16* OB) {
#pragma unroll
    for (int j = 0; j < 4; ++j) { const int col = 512 * j + 8 * lane;
        float o[8], z[8]; unpack8(R.oa[j], o); unpack8(R.z[j], z);
        float ss = 0.f;
#pragma unroll
        for (int e = 0; e < 8; ++e) ss += o[e] * o[e];
        ss += __shfl_xor(ss, 1); ss += __shfl_xor(ss, 2); ss += __shfl_xor(ss, 4); ss += __shfl_xor(ss, 8);
        const float rstd = rsqrtf(ss * (1.f / 128.f) + EPS);
        const float* gp = o_gain + (col & 127);
#pragma unroll
        for (int e = 0; e < 8; ++e) o[e] = o[e] * rstd * gp[e] * silu_(z[e]);
        *(u32x4*)(OAN + (size_t)m * (CATAB ? 3072 : 2048) + col) = pack8(o); }
#pragma unroll
    for (int j = 0; j < 2; ++j) { const int col = 512 * j + 8 * lane;
        const float l0 = R.l[j][0], l1 = R.l[j][1], l2 = R.l[j][2];
        const float mx = fmaxf(l0, fmaxf(l1, l2)); float a0 = fexp(l0 - mx), a1 = fexp(l1 - mx), a2 = fexp(l2 - mx); const float rs = __builtin_amdgcn_rcpf(a0 + a1 + a2); a0 *= rs; a1 *= rs; a2 *= rs;
        float o0[8], o1[8], o2[8]; unpack8(R.so[j][0], o0); unpack8(R.so[j][1], o1); unpack8(R.so[j][2], o2);
#pragma unroll
        for (int e = 0; e < 8; ++e) o0[e] = a0 * o0[e] + a1 * o1[e] + a2 * o2[e];
        *(u32x4*)(OB + (size_t)m * (CATAB ? 3072 : 1024) + col) = pack8(o0); }
}
__device__ __forceinline__ void phase_merge(Frame& F) {
    const int gw = F.vcu * NWAVES + F.wave, NGW = F.G * NWAVES, lane = F.lane;
    const bf16* OA = WSP(bf16, WS_OA); const bf16* Z = WSP(bf16, WS_Z); bf16* OAN = WSP(bf16, WS_OAN);
    const bf16* SO = WSP(bf16, WS_SWAO); const float* LSE = WSP(float, WS_LSE); bf16* OB = CATAB ? OAN + 2048 : WSP(bf16, WS_OB); const float* o_gain = karg<I_OGAIN>();
    MergeRow Ra, Rb;
    if (gw < M) merge_load(Ra, gw, lane, OA, Z, SO, LSE);
    for (int m = gw; m < M; m += 2 * NGW) {
        if (m + NGW < M) merge_load(Rb, m + NGW, lane, OA, Z, SO, LSE);
        merge_finish(Ra, m, lane, o_gain, OAN, OB);
        if (m + NGW < M) { if (m + 2 * NGW < M) merge_load(Ra, m + 2 * NGW, lane, OA, Z, SO, LSE);
            merge_finish(Rb, m + NGW, lane, o_gain, OAN, OB); }
    }
}


struct Args { const void* in[19]; float* out; unsigned char* ws; int ph_lo, ph_hi; };
#ifndef PG8_ALIGN
#define PG8_ALIGN true
#endif
#ifndef PG8_SP2
#define PG8_SP2 true
#endif
#ifndef STG2
#define STG2 0
#endif
#ifndef STG10
#define STG10 0
#endif
#ifndef STG12
#define STG12 0
#endif
#ifndef STGMODE
#define STGMODE 0
#endif
template <int Q> __device__ __forceinline__ void xcd_skew() { if (Q > 0) { const int n = Q * (STGMODE == 0 ? (int)(blockIdx.x & 7) : (int)((blockIdx.x >> 3) & 3)); for (int i = 0; i < n; ++i) __builtin_amdgcn_s_sleep(32); } }
__global__ void __launch_bounds__(NTHR, 2) mega_fwd(Args args) {
    extern __shared__ __attribute__((aligned(16))) unsigned char lds_raw[];
    Frame F;
    F.lds = (LAS unsigned char*)lds_raw;
    F.tid = threadIdx.x; F.lane = F.tid & 63; F.wave = __builtin_amdgcn_readfirstlane(F.tid >> 6);
    F.G = gridDim.x; { const int bx = blockIdx.x; F.vcu = (F.G % 8 == 0) ? (bx % 8) * (F.G / 8) + bx / 8 : bx; }
    F.out = args.out; F.ws = args.ws;
    volatile LAS unsigned* MISC = (volatile LAS unsigned*)(F.lds + MISC_OFF);
    if (F.tid < 64) MISC[F.tid] = 0u;
    __syncthreads();
    unsigned* barw = (unsigned*)(F.ws + WS_CTL) + CW_BAR;
    XcdBarrier bar; bar.bar = barw; bar.x = 0; bar.st = nullptr;
    const int lo = args.ph_lo, hi = args.ph_hi;
    if (hi - lo > 1) bar = xcd_barrier_post(barw, MISC + 8);
#ifndef PH_MASK
#define PH_MASK 0x1FFF
#endif
#define IN(k) (((PH_MASK >> (k)) & 1) && lo <= (k) && (k) < hi)
#ifndef PH_REP
#define PH_REP 0
#endif
#define REPS(k) (1 + ((PH_REP >> (k)) & 1))
#define SEAM(k) do { if ((k) != 6 && IN(k) && IN((k) + 1 + ((k) == 10))) xcd_barrier(bar); } while (0)
    const float* mod = WSP(float, WS_MOD);

    if (IN(0)) _Pragma("unroll") for (int rep = 0; rep < REPS(0); ++rep) { __syncthreads(); phase0(F); } SEAM(0);
    if (IN(1)) _Pragma("unroll") for (int rep = 0; rep < REPS(1); ++rep) { __syncthreads(); phase_norm_mod<true, I8_PROJ != 0>(F, karg<I_X>(), 0, 1, WSP(bf16, WS_H), WSP(float, WS_SA_IN)); phase_quant_weights(F); } SEAM(1);
    if (IN(2)) _Pragma("unroll") for (int rep = 0; rep < REPS(2); ++rep) { __syncthreads();
        typedef pg8::EpiProj<I8_PROJ != 0> EP; typedef std::conditional<I8_PROJ != 0, pg8::MmaI8, pg8::MmaBf16>::type MM;
        constexpr int NPROJ = I8_PROJ ? N_IN_PAD - 256 : N_IN_PAD;
        pg8::Gemm g{WSP(pg8::bf16_t, WS_H), WSP(pg8::bf16_t, WS_BT_IN), M, NPROJ, I8_PROJ ? D / 2 : D}; pg8::StaticOrder S; S.init(M, NPROJ, F.G, (int)blockIdx.x);
        EP E{F.ws, WS_QKVA, WS_Z, WS_QKVB, WS_GATES, WS_BG, WS_SMALL, WS_SA_IN, WS_SB_IN};
#ifdef PROBE_NULL2
        { pg8::EpiNull EN; pg8::gemm_phase<pg8::EpiNull, pg8::StaticOrder, PG8_ALIGN, PG8_SP2, pg8::AMapNat, MM>(F.lds, g, S, EN); __syncthreads(); }
#endif
#ifdef PROBE_R1
        { typedef pg8::EpiProj<I8_PROJ != 0, PROBE_R1> EPF; EPF EF{F.ws, WS_QKVA, WS_Z, WS_QKVB, WS_GATES, WS_BG, WS_SMALL, WS_SA_IN, WS_SB_IN};
          pg8::gemm_phase<EPF, pg8::StaticOrder, PG8_ALIGN, PG8_SP2, pg8::AMapNat, MM>(F.lds, g, S, EF); __syncthreads(); }
#endif
#ifdef PROBE_R0
        { pg8::gemm_phase<EP, pg8::StaticOrder, PG8_ALIGN, PG8_SP2, pg8::AMapNat, MM>(F.lds, g, S, E); __syncthreads(); }
#endif
#ifdef PROBE_SCR2
        {
#ifdef PROBE_FRESH
        pg8::EpiScratch EN{F.ws, WS_RB};
#else
        pg8::EpiScratch EN{F.ws, WS_RC};
#endif
        pg8::gemm_phase<pg8::EpiScratch, pg8::StaticOrder, PG8_ALIGN, PG8_SP2, pg8::AMapNat, MM>(F.lds, g, S, EN); __syncthreads(); }
#endif
        xcd_skew<STG2>();
        pg8::gemm_phase<EP, pg8::StaticOrder, PG8_ALIGN, PG8_SP2, pg8::AMapNat, MM>(F.lds, g, S, E);
        if (I8_PROJ) phase_bg_mini(F);
    } SEAM(2);
    if (IN(3)) _Pragma("unroll") for (int rep = 0; rep < REPS(3); ++rep) { __syncthreads(); __syncthreads(); { int cached_h = -1; for (int ci = F.vcu; ci < 4096; ci += F.G) d1_item(F, ci, cached_h); } } SEAM(3);
    if (IN(4)) _Pragma("unroll") for (int rep = 0; rep < REPS(4); ++rep) { __syncthreads();
        __syncthreads();
        if (F.vcu < 64) { _Pragma("unroll") for (int r2 = 0; r2 < REPS(13); ++r2) d2_item(F, F.vcu); } else { _Pragma("unroll") for (int r2 = 0; r2 < REPS(14); ++r2) for (int u = F.vcu - 64; u < 3072; u += F.G - 64) swa_unit(F, u); }
    } SEAM(4);
    if (IN(5)) _Pragma("unroll") for (int rep = 0; rep < REPS(5); ++rep) { __syncthreads(); phase_merge(F); } SEAM(5);
#if CATAB
    if (IN(6)) { __syncthreads();
        pg8::Gemm g{WSP(pg8::bf16_t, WS_OAN), WSP(pg8::bf16_t, WS_BT_A), M, D, 3072}; pg8::StaticOrder S; S.init(M, D, F.G, (int)blockIdx.x);
        pg8::EpiGatedCat E{WSP(pg8::bf16_t, WS_TM), WSP(pg8::bf16_t, WS_GATES), I8_O ? (unsigned*)(F.ws + WS_RM_O) : nullptr};
        pg8::gemm_phase<pg8::EpiGatedCat, pg8::StaticOrder, PG8_ALIGN, PG8_SP2, pg8::AMapNat, pg8::MmaBf16, 32>(F.lds, g, S, E);
    } SEAM(7);
#else
    if (IN(6)) _Pragma("unroll") for (int rep = 0; rep < REPS(6); ++rep) { __syncthreads();
        pg8::Gemm g{WSP(pg8::bf16_t, WS_OAN), WSP(pg8::bf16_t, WS_BT_A), M, D, 2048}; pg8::StaticOrder S; S.init(M, D, F.G, (int)blockIdx.x);
        pg8::EpiGated<0> E{WSP(pg8::bf16_t, WS_TM), WSP(pg8::bf16_t, WS_GATES), 0, nullptr};
        pg8::gemm_phase<pg8::EpiGated<0>, pg8::StaticOrder, PG8_ALIGN, PG8_SP2>(F.lds, g, S, E);
    } SEAM(6);
    if (IN(7)) _Pragma("unroll") for (int rep = 0; rep < REPS(7); ++rep) { __syncthreads();
        pg8::Gemm g{WSP(pg8::bf16_t, WS_OB), WSP(pg8::bf16_t, WS_BT_B), M, D, 1024}; pg8::StaticOrder S; S.init(M, D, F.G, (int)blockIdx.x);
        pg8::EpiGated<1> E{WSP(pg8::bf16_t, WS_TM), WSP(pg8::bf16_t, WS_GATES), 4096, I8_O ? (unsigned*)(F.ws + WS_RM_O) : nullptr};
        pg8::gemm_phase<pg8::EpiGated<1>, pg8::StaticOrder, PG8_ALIGN, PG8_SP2>(F.lds, g, S, E);
    } SEAM(7);
#endif
    if (IN(8)) _Pragma("unroll") for (int rep = 0; rep < REPS(8); ++rep) { __syncthreads();
#if X1B
        typedef pg8::EpiResidP<I8_O != 0, 0> ER;
#else
        typedef pg8::EpiResid<I8_O != 0> ER;
#endif
        typedef std::conditional<I8_O != 0, pg8::MmaI8, pg8::MmaBf16>::type MO;
        if (I8_O) { phase_quant_rows(F); xcd_barrier(bar); }
        pg8::Gemm g{I8_O ? WSP(pg8::bf16_t, WS_TMQ) : WSP(pg8::bf16_t, WS_TM), WSP(pg8::bf16_t, WS_BT_O), M, D, I8_O ? D / 2 : D}; pg8::StaticOrder S; S.init(M, D, F.G, (int)blockIdx.x);
#if X1B
        ER E{karg<I_X>(), F.ws + WS_X1B, mod + 2 * D, WSP(float, WS_SA_O), WSP(float, WS_SB_O)};
#else
        ER E{karg<I_X>(), F.out, mod + 2 * D, WSP(float, WS_SA_O), WSP(float, WS_SB_O)};
#endif
        pg8::gemm_phase<ER, pg8::StaticOrder, PG8_ALIGN, PG8_SP2, pg8::AMapNat, MO>(F.lds, g, S, E);
    } SEAM(8);
#if X1B
    if (IN(9)) _Pragma("unroll") for (int rep = 0; rep < REPS(9); ++rep) { __syncthreads(); phase_norm_mod_b16(F, WSP(bf16, WS_X1B), 3, 4, WSP(bf16, WS_H2)); } SEAM(9);
#else
    if (IN(9)) _Pragma("unroll") for (int rep = 0; rep < REPS(9); ++rep) { __syncthreads(); phase_norm_mod<false, I8_UP != 0>(F, F.out, 3, 4, WSP(bf16, WS_H2), WSP(float, WS_SA_UP)); } SEAM(9);
#endif
    if (IN(10)) _Pragma("unroll") for (int rep = 0; rep < REPS(10); ++rep) { __syncthreads();
        typedef pg8::EpiUpConv<I8_UP != 0> EU; typedef std::conditional<I8_UP != 0, pg8::MmaI8, pg8::MmaBf16>::type MU;
        pg8::Gemm g{WSP(pg8::bf16_t, WS_H2), WSP(pg8::bf16_t, WS_BT_UP), 65 * 256, 2 * DFF, I8_UP ? D / 2 : D}; pg8::StaticOrder S; S.init(65 * 256, 2 * DFF, F.G, (int)blockIdx.x);
        EU E{WSP(pg8::bf16_t, WS_ACT), karg<I_CONVFFN>(), (PG8_LAS float*)(F.lds + XL_OFF), WSP(float, WS_SA_UP), WSP(float, WS_SB_UP), M};
        xcd_skew<STG10>();
        pg8::gemm_phase<EU, pg8::StaticOrder, true, PG8_SP2, pg8::AMapConv, MU>(F.lds, g, S, E);
    } SEAM(10);
    if (IN(12)) _Pragma("unroll") for (int rep = 0; rep < REPS(12); ++rep) { __syncthreads();
        pg8::Gemm g{WSP(pg8::bf16_t, WS_ACT), WSP(pg8::bf16_t, WS_BT_DN), M, D, DFF}; pg8::StaticOrder S; S.init(M, D, F.G, (int)blockIdx.x);
#if X1B
        pg8::EpiResidP<false, 1> E{F.ws + WS_X1B, F.out, mod + 5 * D, nullptr, nullptr};
        pg8::gemm_phase<pg8::EpiResidP<false, 1>, pg8::StaticOrder, PG8_ALIGN, PG8_SP2>(F.lds, g, S, E);
#else
        pg8::EpiResid<false> E{F.out, (REPS(12) > 1 && rep == 0) ? WSP(float, WS_RA) : F.out, mod + 5 * D, nullptr, nullptr};
        xcd_skew<STG12>();
        pg8::gemm_phase<pg8::EpiResid<false>, pg8::StaticOrder, PG8_ALIGN, PG8_SP2>(F.lds, g, S, E);
#endif
    }
#undef IN
#undef SEAM
}

extern "C" void kernel_launch(void* const* d_in, const int* in_sizes, int n_in, void* d_out, int out_size, void* d_ws, size_t ws_size, hipStream_t stream) {
    static int grid = 0;
    if (grid == 0) {
        if (n_in != 19 || in_sizes[0] != M * D || out_size != M * D || ws_size < WS_END) { fprintf(stderr, "kernel_launch: unexpected shapes / workspace (n_in %d, in0 %d, out %d, ws %zu < %zu); nothing launched\n", n_in, n_in > 0 ? in_sizes[0] : -1, out_size, ws_size, (size_t)WS_END); grid = -1; return; }
        int dev = 0, cus = 0, per_cu = 0;
        if (hipGetDevice(&dev) != hipSuccess || hipDeviceGetAttribute(&cus, hipDeviceAttributeMultiprocessorCount, dev) != hipSuccess) { grid = -1; return; }
        if (hipFuncSetAttribute((const void*)mega_fwd, hipFuncAttributeMaxDynamicSharedMemorySize, LDS_BYTES) != hipSuccess) { fprintf(stderr, "kernel_launch: hipFuncSetAttribute failed\n"); grid = -1; return; }
        if (hipOccupancyMaxActiveBlocksPerMultiprocessor(&per_cu, (const void*)mega_fwd, NTHR, LDS_BYTES) != hipSuccess || per_cu < 1) { fprintf(stderr, "kernel_launch: occupancy query reports %d blocks per CU\n", per_cu); }
        (void)hipGetLastError();
        grid = cus;
        if (grid <= 64) { fprintf(stderr, "kernel_launch: needs more than 64 CUs (got %d); nothing launched\n", grid); grid = -1; return; }
    }
    if (grid < 0) return;
    if (hipMemsetAsync((char*)d_ws + WS_CTL, 0, CTL_ZERO_BYTES, stream) != hipSuccess) { fprintf(stderr, "kernel_launch: memset failed\n"); return; }
    Args a{};
    for (int i = 0; i < 19; ++i) a.in[i] = d_in[i];
    a.out = (float*)d_out; a.ws = (unsigned char*)d_ws;
    a.ph_lo = 0; a.ph_hi = N_PHASES;
    hipLaunchKernelGGL(mega_fwd, dim3(grid), dim3(NTHR), LDS_BYTES, stream, a);
    const hipError_t le = hipPeekAtLastError();
    if (le != hipSuccess) fprintf(stderr, "kernel_launch: launch failed: %s\n", hipGetErrorName(le));
}
```
